# Optimizing an MI355X kernel written in HIP

```python
import jax, jax.numpy as jnp
from jax import lax
import numpy as np

D_MODEL = 2048
BATCH = 2
SEQ = 8192
DEPTH = 1

CHUNK = 64
Q_BLOCK = 128
SB_HEADS = 8
SB_HEAD_DIM = 128
SB_WIDTH = SB_HEADS * SB_HEAD_DIM
SA_HEADS = 8
SA_HEAD_DIM = 128
SA_WIDTH = SA_HEADS * SA_HEAD_DIM
IDX_HEADS = 16
IDX_DIM = 64
TOPK_MAX = 256
RMS_EPS = 1e-6
IN_WIDTH = 4 * SB_WIDTH + 4 * SA_WIDTH + IDX_HEADS * IDX_DIM + IDX_DIM + IDX_HEADS + 2 * D_MODEL

kernel_name = "hybrid_stickbreak_dsa_gated_block"


def _split_points():
    sizes = [SB_WIDTH] * 4 + [SA_WIDTH] * 4 + [IDX_HEADS * IDX_DIM, IDX_DIM, IDX_HEADS, D_MODEL, D_MODEL]
    return [int(c) for c in np.cumsum(sizes)[:-1]]


def rms_norm(x, g):
    xf = x.astype(jnp.float32)
    y = xf * lax.rsqrt(jnp.mean(xf * xf, axis=-1, keepdims=True) + RMS_EPS)
    return (y * g.astype(jnp.float32)).astype(x.dtype)


def alibi_slopes(n_heads):
    return jnp.exp2(-8.0 * (jnp.arange(n_heads, dtype=jnp.float32) + 1.0) / n_heads)


def stick_breaking_attention(q, k, v):
    b, s, h, dh = q.shape
    scale = dh ** -0.5
    kpos = jnp.arange(s)

    def block(i):
        start = i * Q_BLOCK
        qb = lax.dynamic_slice_in_dim(q, start, Q_BLOCK, axis=1)
        qpos = start + jnp.arange(Q_BLOCK)
        z = jnp.einsum('bqhd,bshd->bhqs', qb, k).astype(jnp.float32) * scale
        strict = kpos[None, :] < qpos[:, None]
        log_keep = jnp.where(strict, jax.nn.log_sigmoid(-z), 0.0)
        after = lax.cumsum(log_keep, axis=3, reverse=True) - log_keep
        w = jnp.where(strict, jnp.exp(jax.nn.log_sigmoid(z) + after), 0.0)
        return jnp.einsum('bhqs,bshd->bqhd', w.astype(v.dtype), v)

    out = lax.map(block, jnp.arange(s // Q_BLOCK))
    return jnp.moveaxis(out, 0, 1).reshape(b, s, h, dh)


def indexed_sparse_attention(q, k, v, q_idx, k_idx, w_idx):
    b, s, h, dh = q.shape
    n_sel = min(TOPK_MAX, s // 4)
    kpos = jnp.arange(s)
    slopes = alibi_slopes(h)

    def block(i):
        start = i * Q_BLOCK
        qpos = start + jnp.arange(Q_BLOCK)
        visible = kpos[None, :] < (qpos[:, None] // CHUNK + 1) * CHUNK
        qi = lax.dynamic_slice_in_dim(q_idx, start, Q_BLOCK, axis=1)
        wi = lax.dynamic_slice_in_dim(w_idx, start, Q_BLOCK, axis=1).astype(jnp.float32) * IDX_HEADS ** -0.5
        dots = jnp.einsum('bqhd,bsd->bqhs', qi, k_idx).astype(jnp.float32) * IDX_DIM ** -0.5
        score = jnp.einsum('bqhs,bqh->bqs', jax.nn.relu(dots), wi)
        score = jnp.where(visible[None], score, -jnp.inf)
        top_val, top_idx = lax.top_k(score, n_sel)
        valid = jnp.isfinite(top_val)
        kg = jax.vmap(lambda kk, ii: kk[ii])(k, top_idx)
        vg = jax.vmap(lambda vv, ii: vv[ii])(v, top_idx)
        qb = lax.dynamic_slice_in_dim(q, start, Q_BLOCK, axis=1)
        logits = jnp.einsum('bqhd,bqkhd->bhqk', qb, kg).astype(jnp.float32) * dh ** -0.5
        dist = jnp.abs(qpos[None, :, None] - top_idx).astype(jnp.float32)
        logits = logits - slopes[None, :, None, None] * dist[:, None]
        logits = jnp.where(valid[:, None], logits, -jnp.inf)
        p = jax.nn.softmax(logits, axis=-1)
        return jnp.einsum('bhqk,bqkhd->bqhd', p.astype(v.dtype), vg)

    out = lax.map(block, jnp.arange(s // Q_BLOCK))
    return jnp.moveaxis(out, 0, 1).reshape(b, s, h, dh)


def setup_inputs(seed: int = 0) -> dict:
    key = jax.random.key(seed)
    ks = jax.random.split(key, 7)
    x = jax.random.normal(ks[0], (BATCH, SEQ, D_MODEL), jnp.float32)
    norm_gain = 1.0 + 0.01 * jax.random.normal(ks[1], (DEPTH, D_MODEL), jnp.float32)
    w_in = jax.random.normal(ks[2], (DEPTH, D_MODEL, IN_WIDTH), jnp.float32) * D_MODEL ** -0.5
    w_branch_sb = jax.random.normal(ks[3], (DEPTH, SB_WIDTH, D_MODEL), jnp.float32) * SB_WIDTH ** -0.5
    w_branch_sa = jax.random.normal(ks[4], (DEPTH, SA_WIDTH, D_MODEL), jnp.float32) * SA_WIDTH ** -0.5
    w_out = jax.random.normal(ks[5], (DEPTH, D_MODEL, D_MODEL), jnp.float32) * D_MODEL ** -0.5
    final_norm_gain = 1.0 + 0.01 * jax.random.normal(ks[6], (D_MODEL,), jnp.float32)
    return {"x": x, "norm_gain": norm_gain, "w_in": w_in, "w_branch_sb": w_branch_sb,
            "w_branch_sa": w_branch_sa, "w_out": w_out, "final_norm_gain": final_norm_gain}


def reference(x, norm_gain, w_in, w_branch_sb, w_branch_sa, w_out, final_norm_gain):
    b, s, _ = x.shape
    h = x
    splits = _split_points()
    for layer in range(DEPTH):
        u = rms_norm(h, norm_gain[layer])
        proj = jnp.einsum('bsd,de->bse', u, w_in[layer])
        (q_sb, k_sb, v_sb, z_sb, q_sa, k_sa, v_sa, z_sa,
         q_ix, k_ix, w_ix, g_sb, g_sa) = jnp.split(proj, splits, axis=-1)
        o_sb = stick_breaking_attention(q_sb.reshape(b, s, SB_HEADS, SB_HEAD_DIM),
                                        k_sb.reshape(b, s, SB_HEADS, SB_HEAD_DIM),
                                        v_sb.reshape(b, s, SB_HEADS, SB_HEAD_DIM))
        y_sb = jnp.einsum('bse,ed->bsd', o_sb.reshape(b, s, SB_WIDTH) * jax.nn.silu(z_sb), w_branch_sb[layer])
        o_sa = indexed_sparse_attention(q_sa.reshape(b, s, SA_HEADS, SA_HEAD_DIM),
                                        k_sa.reshape(b, s, SA_HEADS, SA_HEAD_DIM),
                                        v_sa.reshape(b, s, SA_HEADS, SA_HEAD_DIM),
                                        q_ix.reshape(b, s, IDX_HEADS, IDX_DIM), k_ix, w_ix)
        y_sa = jnp.einsum('bse,ed->bsd', o_sa.reshape(b, s, SA_WIDTH) * jax.nn.silu(z_sa), w_branch_sa[layer])
        mixed = jax.nn.sigmoid(g_sb) * y_sb + jax.nn.sigmoid(g_sa) * y_sa
        h = h + jnp.einsum('bsd,de->bse', mixed, w_out[layer])
    return rms_norm(h, final_norm_gain)
```

```cpp
#define PROBE_MODE 0
#include <hip/hip_runtime.h>
#include <hip/hip_bf16.h>
#include <cstdio>
#include <cstdint>
namespace pg8 {
#define PG8_LAS __attribute__((address_space(3)))
typedef unsigned short bf16_t;
typedef short bf16x8 __attribute__((ext_vector_type(8)));
typedef float f32x4 __attribute__((ext_vector_type(4)));
typedef unsigned u32x4 __attribute__((ext_vector_type(4)));
constexpr int BM = 256, BK = 64, HALF = 128, HTB = HALF * BK * 2  , STAGE_BYTES = 8 * HTB, NXCD = 8, WGM = 8;

__host__ __device__ __forceinline__ int lds_byte(int r, int c) { const int st = (r >> 4) * 2 + (c >> 5), rr = r & 15, cc = c & 31, ob = rr * 64 + cc * 2; return st * 1024 + (ob ^ (((ob >> 9) & 1) << 5)); }
__host__ __device__ __forceinline__ void stage_rc(int b, int& R, int& C) { const int st = b / 1024, sb = b % 1024, swz = sb ^ (((sb >> 9) & 1) << 5); R = (st >> 1) * 16 + swz / 64; C = (st & 1) * 32 + (swz % 64) / 2; }
__host__ __device__ __forceinline__ int perm32(int rho) { const int n = rho >> 4, i = rho & 15; return 8 * (i >> 2) + 4 * n + (i & 3); }

struct Unit { int pm, pn; };
struct Gemm { const bf16_t* A; const bf16_t* Bt; int M, N, K; };

struct StaticOrder {
    int nM, nN, nwg, G, c;
    __host__ __device__ void init(int M, int N, int G_, int c_) { nM = M / BM; nN = N / BM; nwg = nM * nN; G = G_; c = c_; }
    __host__ __device__ bool next(int i, Unit& u) const {
        const long L = (long)i * G + c; if (L >= nwg) return false;
        int wgid = (int)L; { const int q = nwg / NXCD, r = nwg % NXCD, xcd = wgid % NXCD, off = wgid / NXCD; wgid = (xcd < r ? xcd * (q + 1) : r * (q + 1) + (xcd - r) * q) + off; }
        const int nig = WGM * nN, gid = wgid / nig, fm = gid * WGM, gsz = (nM - fm) < WGM ? (nM - fm) : WGM;
        u.pm = fm + ((wgid % nig) % gsz); u.pn = (wgid % nig) / gsz; return true;
    }
    __device__ __forceinline__ void a_ready(const Unit&) const {}
    __device__ __forceinline__ void done(const Unit&) const {}
};

typedef float cvt_f32x2_t __attribute__((ext_vector_type(2))); typedef __bf16 cvt_bf16x2_t __attribute__((ext_vector_type(2)));
__device__ __forceinline__ unsigned cvt_pk_bf16(float lo, float hi) { cvt_f32x2_t v = {lo, hi}; cvt_bf16x2_t b = __builtin_convertvector(v, cvt_bf16x2_t); return __builtin_bit_cast(unsigned, b); }
typedef float f32x2 __attribute__((ext_vector_type(2)));
constexpr int EM = 16384;
#ifndef PROBE_MODE
#define PROBE_MODE 0
#endif
__device__ __forceinline__ float bf_lo(unsigned w) { return __uint_as_float(w << 16); }
__device__ __forceinline__ float bf_hi(unsigned w) { return __uint_as_float(w & 0xffff0000u); }
__device__ __forceinline__ float sigmoid_f(float v) { return __builtin_amdgcn_rcpf(1.0f + __builtin_amdgcn_exp2f(-1.4426950408889634f * v)); }
__device__ __forceinline__ float silu_f(float v) { return v * sigmoid_f(v); }
template <int ACT> __device__ __forceinline__ f32x4 act4(f32x4 v) {
    if (ACT == 1) { v[0] = silu_f(v[0]); v[1] = silu_f(v[1]); v[2] = silu_f(v[2]); v[3] = silu_f(v[3]); }
    if (ACT == 2) { v[0] = sigmoid_f(v[0]); v[1] = sigmoid_f(v[1]); v[2] = sigmoid_f(v[2]); v[3] = sigmoid_f(v[3]); }
    return v;
}
struct EpiProj {
    static constexpr bool PERM = true, AFTER_DRAIN = false;
    bf16_t* P9; bf16_t* G; bf16_t* kidx; float* widx;
    template <int ACT> __device__ __forceinline__ void tile(const f32x4 (&acc)[2][2][4][2], bf16_t* base, int ldc, int row0, int col0) const {
#pragma unroll
        for (int ai = 0; ai < 2; ++ai)
#pragma unroll
            for (int m = 0; m < 4; ++m) { bf16_t* rowp = base + (size_t)(row0 + ai * HALF + m * 16) * ldc + col0;
#pragma unroll
                for (int bj = 0; bj < 2; ++bj) { const f32x4 v0 = act4<ACT>(acc[ai][bj][m][0]), v1 = act4<ACT>(acc[ai][bj][m][1]);
                    u32x4 w; w.x = cvt_pk_bf16(v0[0], v0[1]); w.y = cvt_pk_bf16(v0[2], v0[3]); w.z = cvt_pk_bf16(v1[0], v1[1]); w.w = cvt_pk_bf16(v1[2], v1[3]);
                    *(u32x4*)(rowp + bj * HALF) = w; } }
    }
    __device__ __forceinline__ void operator()(const f32x4 (&acc)[2][2][4][2], const Unit& u, int wr, int wc, int fr, int fq) const {
        const int pn = u.pn, row0 = u.pm * BM + wr * 64 + fr;
        if (pn < 36) { const int t = pn >> 2; bf16_t* base = P9 + (size_t)t * ((size_t)EM * 1024); const int col0 = (pn & 3) * 256 + wc * 32 + 8 * fq;
            if (t == 3 || t == 7) tile<1>(acc, base, 1024, row0, col0); else tile<0>(acc, base, 1024, row0, col0); }
        else if (pn < 52) { tile<2>(acc, G, 4096, row0, (pn - 36) * 256 + wc * 32 + 8 * fq); }
        else {
            if (wc < 2) {
#pragma unroll
                for (int ai = 0; ai < 2; ++ai)
#pragma unroll
                    for (int m = 0; m < 4; ++m) { const f32x4 v0 = acc[ai][0][m][0], v1 = acc[ai][0][m][1];
                        u32x4 w; w.x = cvt_pk_bf16(v0[0], v0[1]); w.y = cvt_pk_bf16(v0[2], v0[3]); w.z = cvt_pk_bf16(v1[0], v1[1]); w.w = cvt_pk_bf16(v1[2], v1[3]);
                        *(u32x4*)(kidx + (size_t)(row0 + ai * HALF + m * 16) * 64 + wc * 32 + 8 * fq) = w; }
            } else if (wc == 2 && fq < 2) {
#pragma unroll
                for (int ai = 0; ai < 2; ++ai)
#pragma unroll
                    for (int m = 0; m < 4; ++m) { float* p = widx + (size_t)(row0 + ai * HALF + m * 16) * 16 + 8 * fq;
                        *(f32x4*)p = acc[ai][0][m][0]; *(f32x4*)(p + 4) = acc[ai][0][m][1]; }
            }
        }
    }
};
template <int MODE> struct EpiGate {
    static constexpr bool PERM = true, AFTER_DRAIN = false;
    const bf16_t* G; int gcol0; const bf16_t* Tin; bf16_t* Tout;
    __device__ __forceinline__ void operator()(const f32x4 (&acc)[2][2][4][2], const Unit& u, int wr, int wc, int fr, int fq) const {
        const int row0 = u.pm * BM + wr * 64 + fr, col0 = u.pn * BM + wc * 32 + 8 * fq;
#pragma unroll
        for (int ai = 0; ai < 2; ++ai)
#pragma unroll
            for (int m = 0; m < 4; ++m) { const size_t row = (size_t)(row0 + ai * HALF + m * 16);
#pragma unroll
                for (int bj = 0; bj < 2; ++bj) {
                    const u32x4 g = *(const u32x4*)(G + row * 4096 + (PROBE_MODE == 17 ? 2048 - gcol0 : gcol0) + col0 + bj * HALF);
                    f32x4 v0 = acc[ai][bj][m][0], v1 = acc[ai][bj][m][1];
                    if ((PROBE_MODE == 3 && MODE == 0) || (PROBE_MODE == 2 && MODE == 1)) { v0 = v0 * 0.f; v1 = v1 * 0.f; }
                    if (PROBE_MODE == 8 && MODE == 1) { v0 = v0 * 0.5f; v1 = v1 * 0.5f; }
                    if (PROBE_MODE == 10 || (PROBE_MODE == 14 && MODE == 1) || (PROBE_MODE == 15 && MODE == 0)) { v0 = v0 * 0.5f; v1 = v1 * 0.5f; } else {
                    float gg[8] = {bf_lo(g.x), bf_hi(g.x), bf_lo(g.y), bf_hi(g.y), bf_lo(g.z), bf_hi(g.z), bf_lo(g.w), bf_hi(g.w)};
                    if (PROBE_MODE == 20) { for (int e_ = 0; e_ < 8; ++e_) if (!(gg[e_] > 0.02f && gg[e_] < 0.98f)) gg[e_] = 0.5f; }
                    if (PROBE_MODE == 21) { for (int e_ = 0; e_ < 8; ++e_) if (!(gg[e_] >= 0.0f && gg[e_] <= 1.0f)) gg[e_] = 0.5f; }
                    if (PROBE_MODE == 25 && (gcol0 + col0 + bj * HALF) >= 3840) { for (int e_ = 0; e_ < 8; ++e_) if (!(gg[e_] >= 0.0f && gg[e_] <= 1.0f)) gg[e_] = 0.5f; }
                    if (PROBE_MODE == 26 && (gcol0 + col0 + bj * HALF) < 2048) { for (int e_ = 0; e_ < 8; ++e_) if (!(gg[e_] >= 0.0f && gg[e_] <= 1.0f)) gg[e_] = 0.5f; }
                    if (PROBE_MODE == 27 && row < 8192) { for (int e_ = 0; e_ < 8; ++e_) if (!(gg[e_] >= 0.0f && gg[e_] <= 1.0f)) gg[e_] = 0.5f; }
                    if (PROBE_MODE == 28 && (row & 255) < 128) { for (int e_ = 0; e_ < 8; ++e_) if (!(gg[e_] >= 0.0f && gg[e_] <= 1.0f)) gg[e_] = 0.5f; }
                    if (PROBE_MODE == 22) { for (int e_ = 0; e_ < 8; ++e_) if (!(gg[e_] > 1e-4f)) gg[e_] = 0.5f; }
                    v0[0] *= gg[0]; v0[1] *= gg[1]; v0[2] *= gg[2]; v0[3] *= gg[3];
                    v1[0] *= gg[4]; v1[1] *= gg[5]; v1[2] *= gg[6]; v1[3] *= gg[7]; }
                    if (MODE == 1) { const u32x4 t = *(const u32x4*)(Tin + row * 2048 + col0 + bj * HALF);
                        v0[0] += bf_lo(t.x); v0[1] += bf_hi(t.x); v0[2] += bf_lo(t.y); v0[3] += bf_hi(t.y);
                        v1[0] += bf_lo(t.z); v1[1] += bf_hi(t.z); v1[2] += bf_lo(t.w); v1[3] += bf_hi(t.w); }
                    u32x4 w; w.x = cvt_pk_bf16(v0[0], v0[1]); w.y = cvt_pk_bf16(v0[2], v0[3]); w.z = cvt_pk_bf16(v1[0], v1[1]); w.w = cvt_pk_bf16(v1[2], v1[3]);
                    *(u32x4*)(Tout + row * 2048 + col0 + bj * HALF) = w; }
                asm volatile("" ::: "memory"); }
    }
};
struct EpiOut {
    static constexpr bool PERM = false, AFTER_DRAIN = false;
    const float* x; float* h; float* pss;
    __device__ __forceinline__ void operator()(const f32x4 (&acc)[2][2][4][2], const Unit& u, int wr, int wc, int fr, int fq) const {
        const int row0 = u.pm * BM + wr * 64 + fr, col0 = u.pn * BM + wc * 32 + 4 * fq;
#pragma unroll
        for (int ai = 0; ai < 2; ++ai)
#pragma unroll
            for (int m = 0; m < 4; ++m) { const size_t row = (size_t)(row0 + ai * HALF + m * 16); float ss = 0.f;
#pragma unroll
                for (int bj = 0; bj < 2; ++bj)
#pragma unroll
                    for (int n = 0; n < 2; ++n) { const size_t off = row * 2048 + col0 + bj * HALF + n * 16;
                        const f32x4 hv = *(const f32x4*)(x + off) + (PROBE_MODE == 1 ? acc[ai][bj][m][n] * 0.f : acc[ai][bj][m][n]); *(f32x4*)(h + off) = hv;
                        ss += (hv[0] * hv[0] + hv[1] * hv[1]) + (hv[2] * hv[2] + hv[3] * hv[3]); }
                ss += __shfl_xor(ss, 16); ss += __shfl_xor(ss, 32);
                if (fq == 0) pss[row * 32 + u.pn * 4 + wc] = ss;
                asm volatile("" ::: "memory"); }
    }
};

template <class Epi, class Sched, bool ALIGN_EPI = false, bool SP2 = false>
__device__ __forceinline__ void gemm_phase(PG8_LAS unsigned char* lds, const Gemm g, const Sched& S, const Epi& E) {
    const int tid = threadIdx.x, wid = __builtin_amdgcn_readfirstlane(tid >> 6), lane = tid & 63, wr = wid >> 2, wc = wid & 3, fr = lane & 15, fq = lane >> 4;
    const int K = g.K, nt = K / BK;
    unsigned voffA[2], voffB[2];
#pragma unroll
    for (int i = 0; i < 2; ++i) { int R, C; stage_rc(tid * 16 + i * 8192, R, C); const int Rb = Epi::PERM ? ((R & ~31) + perm32(R & 31)) : R;
        voffA[i] = (unsigned)(R * K + C) * 2u; voffB[i] = (unsigned)(Rb * K + C) * 2u; }
    const size_t kstep = (size_t)(BK * 2);
    const size_t hstep = (size_t)HALF * K * 2;
    const size_t tstep = 2 * hstep;
    const unsigned ldsw = (unsigned)wid * 1024u;
    const int aoff = lds_byte(wr * 64 + fr, fq * 8), boff = lds_byte(wc * 32 + fr, fq * 8);
#define PG8_SA(b, h) (((b) * 2 + (h)) * HTB)
#define PG8_SB(b, h) ((4 + (b) * 2 + (h)) * HTB)
#define PG8_STAGE(bufoff, gbase, voff) do { _Pragma("unroll") for (int _i = 0; _i < 2; ++_i) \
        __builtin_amdgcn_global_load_lds((const unsigned*)((const char*)(gbase) + (voff)[_i]), (PG8_LAS unsigned*)(lds + (bufoff) + ldsw + _i * 8192), 16, 0, 0); } while (0)
#define PG8_LDA(dst, b, h) do { _Pragma("unroll") for (int m = 0; m < 4; ++m) _Pragma("unroll") for (int k = 0; k < 2; ++k) dst[m][k] = *(const PG8_LAS bf16x8*)(lds + PG8_SA(b, h) + aoff + m * 2048 + k * 1024); } while (0)
#define PG8_LDB(dst, b, h) do { _Pragma("unroll") for (int n = 0; n < 2; ++n) _Pragma("unroll") for (int k = 0; k < 2; ++k) dst[n][k] = *(const PG8_LAS bf16x8*)(lds + PG8_SB(b, h) + boff + n * 2048 + k * 1024); } while (0)
#define PG8_MMA(ai, bj, At, Bt) do { __builtin_amdgcn_s_setprio(1); _Pragma("unroll") for (int m = 0; m < 4; ++m) _Pragma("unroll") for (int n = 0; n < 2; ++n) _Pragma("unroll") for (int k = 0; k < 2; ++k) \
        acc[ai][bj][m][n] = __builtin_amdgcn_mfma_f32_16x16x32_bf16(Bt[n][k], At[m][k], acc[ai][bj][m][n], 0, 0, 0); __builtin_amdgcn_s_setprio(0); } while (0)
#define PG8_WAIT_V(n) asm volatile("s_waitcnt vmcnt(" #n ")" ::: "memory")
#define PG8_WAIT_L(n) asm volatile("s_waitcnt lgkmcnt(" #n ")" ::: "memory")
#define PG8_BAR __builtin_amdgcn_s_barrier()
#define PG8_SCHED __builtin_amdgcn_sched_barrier(0)
    Unit cur, nxt; int ui = 0;
    if (!S.next(0, cur)) return;
    f32x4 acc[2][2][4][2];
#pragma unroll
    for (int a = 0; a < 2; ++a)
#pragma unroll
        for (int b = 0; b < 2; ++b)
#pragma unroll
            for (int m = 0; m < 4; ++m)
#pragma unroll
                for (int n = 0; n < 2; ++n) acc[a][b][m][n] = (f32x4){0.f, 0.f, 0.f, 0.f};
    bf16x8 At[4][2], B0[2][2], B1[2][2];
    const char* cA = (const char*)g.A + (size_t)cur.pm * tstep; const char* cB = (const char*)g.Bt + (size_t)cur.pn * tstep;
    S.a_ready(cur);
    if constexpr (SP2) {
        PG8_STAGE(PG8_SB(0, 0), cB, voffB); PG8_STAGE(PG8_SB(0, 1), cB + hstep, voffB); PG8_STAGE(PG8_SA(0, 0), cA, voffA); PG8_STAGE(PG8_SA(0, 1), cA + hstep, voffA);
        if (wr == 1) PG8_BAR;
        PG8_WAIT_V(2); PG8_BAR;
        PG8_STAGE(PG8_SB(1, 0), cB + kstep, voffB); PG8_STAGE(PG8_SA(1, 0), cA + kstep, voffA); PG8_STAGE(PG8_SB(1, 1), cB + hstep + kstep, voffB);
        PG8_WAIT_V(6); PG8_BAR;
    } else {
        PG8_STAGE(PG8_SB(0, 0), cB, voffB); PG8_STAGE(PG8_SA(0, 0), cA, voffA); PG8_STAGE(PG8_SB(0, 1), cB + hstep, voffB); PG8_STAGE(PG8_SA(0, 1), cA + hstep, voffA);
        if (wr == 1) PG8_BAR;
        PG8_WAIT_V(4); PG8_BAR;
        PG8_STAGE(PG8_SB(1, 0), cB + kstep, voffB); PG8_STAGE(PG8_SA(1, 0), cA + kstep, voffA); PG8_STAGE(PG8_SB(1, 1), cB + hstep + kstep, voffB);
        PG8_WAIT_V(6); PG8_BAR;
    }
    for (;;) {
        const bool has_next = S.next(ui + 1, nxt);
        const char* nA = has_next ? (const char*)g.A + (size_t)nxt.pm * tstep : cA; const char* nB = has_next ? (const char*)g.Bt + (size_t)nxt.pn * tstep : cB;
        for (int t = 0; t < nt; t += 2) {
            const bool last = (t == nt - 2);
            const char* a1 = cA + (size_t)(t + 1) * kstep;
            const char* a2 = last ? nA : cA + (size_t)(t + 2) * kstep; const char* b2 = last ? nB : cB + (size_t)(t + 2) * kstep;
            const char* a3 = a2 + kstep; const char* b3 = b2 + kstep;
            if (last && has_next) S.a_ready(nxt);
            if constexpr (SP2) {
            PG8_LDB(B0, 0, 0); PG8_LDB(B1, 0, 1); PG8_SCHED; PG8_LDA(At, 0, 0); PG8_STAGE(PG8_SA(1, 1), a1 + hstep, voffA);
            PG8_WAIT_V(8); PG8_WAIT_L(0); PG8_BAR; PG8_MMA(0, 0, At, B0); PG8_MMA(0, 1, At, B1); PG8_BAR; PG8_SCHED;
            PG8_LDA(At, 0, 1); PG8_STAGE(PG8_SB(0, 0), b2, voffB); PG8_STAGE(PG8_SB(0, 1), b2 + hstep, voffB); PG8_STAGE(PG8_SA(0, 0), a2, voffA);
            PG8_WAIT_V(8); PG8_WAIT_L(0); PG8_BAR; PG8_MMA(1, 0, At, B0); PG8_MMA(1, 1, At, B1); PG8_BAR; PG8_SCHED;
            PG8_LDB(B0, 1, 0); PG8_LDB(B1, 1, 1); PG8_SCHED; PG8_LDA(At, 1, 0); PG8_STAGE(PG8_SA(0, 1), a2 + hstep, voffA);
            PG8_WAIT_V(8); PG8_WAIT_L(0); PG8_BAR; PG8_MMA(0, 0, At, B0); PG8_MMA(0, 1, At, B1); PG8_BAR; PG8_SCHED;
            PG8_LDA(At, 1, 1); PG8_STAGE(PG8_SB(1, 0), b3, voffB); PG8_STAGE(PG8_SB(1, 1), b3 + hstep, voffB); PG8_STAGE(PG8_SA(1, 0), a3, voffA);
            PG8_WAIT_V(8); PG8_WAIT_L(0); PG8_BAR; PG8_MMA(1, 0, At, B0); PG8_MMA(1, 1, At, B1); PG8_BAR; PG8_SCHED;
            } else {
            PG8_LDB(B0, 0, 0); PG8_SCHED; PG8_LDA(At, 0, 0); PG8_STAGE(PG8_SA(1, 1), a1 + hstep, voffA);
            PG8_WAIT_L(8); PG8_BAR; PG8_WAIT_L(0); PG8_MMA(0, 0, At, B0); PG8_BAR; PG8_SCHED;
            PG8_LDB(B1, 0, 1); PG8_STAGE(PG8_SB(0, 0), b2, voffB);
            PG8_BAR; PG8_WAIT_L(0); PG8_MMA(0, 1, At, B1); PG8_BAR;
            PG8_LDA(At, 0, 1); PG8_STAGE(PG8_SA(0, 0), a2, voffA);
            PG8_BAR; PG8_WAIT_L(0); PG8_MMA(1, 0, At, B0); PG8_BAR; PG8_SCHED;
            PG8_STAGE(PG8_SB(0, 1), b2 + hstep, voffB);
            PG8_WAIT_V(6); PG8_BAR; PG8_MMA(1, 1, At, B1); PG8_BAR;
            PG8_LDB(B0, 1, 0); PG8_SCHED; PG8_LDA(At, 1, 0); PG8_STAGE(PG8_SA(0, 1), a2 + hstep, voffA);
            PG8_WAIT_L(8); PG8_BAR; PG8_WAIT_L(0); PG8_MMA(0, 0, At, B0); PG8_BAR; PG8_SCHED;
            PG8_LDB(B1, 1, 1); PG8_STAGE(PG8_SB(1, 0), b3, voffB);
            PG8_BAR; PG8_WAIT_L(0); PG8_MMA(0, 1, At, B1); PG8_BAR;
            PG8_LDA(At, 1, 1); PG8_STAGE(PG8_SA(1, 0), a3, voffA);
            PG8_BAR; PG8_WAIT_L(0); PG8_MMA(1, 0, At, B0); PG8_BAR; PG8_SCHED;
            PG8_STAGE(PG8_SB(1, 1), b3 + hstep, voffB);
            PG8_WAIT_V(6); PG8_BAR; PG8_MMA(1, 1, At, B1); PG8_BAR;
            }
        }
        if constexpr (ALIGN_EPI) { if (wr == 0) PG8_BAR; }
        if constexpr (!Epi::AFTER_DRAIN) { E(acc, cur, wr, wc, fr, fq); S.done(cur); }
        if (!has_next) break;
#pragma unroll
        for (int a = 0; a < 2; ++a)
#pragma unroll
            for (int b = 0; b < 2; ++b)
#pragma unroll
                for (int m = 0; m < 4; ++m)
#pragma unroll
                    for (int n = 0; n < 2; ++n) acc[a][b][m][n] = (f32x4){0.f, 0.f, 0.f, 0.f};
        cur = nxt; cA = nA; cB = nB; ++ui;
        if constexpr (ALIGN_EPI) { if (wr == 1) PG8_BAR; }
    }
    PG8_WAIT_V(0);
    if constexpr (!ALIGN_EPI) { if (wr == 0) PG8_BAR; }
    PG8_BAR;
    if constexpr (Epi::AFTER_DRAIN) { E.fused(acc, cur, wr, wc, fr, fq, lds, wid, lane); S.done(cur); }
#undef PG8_SA
#undef PG8_SB
#undef PG8_STAGE
#undef PG8_LDA
#undef PG8_LDB
#undef PG8_MMA
#undef PG8_WAIT_V
#undef PG8_WAIT_L
#undef PG8_BAR
#undef PG8_SCHED
}
}
namespace att {
typedef unsigned short bf16;
using bf16x8 = __attribute__((ext_vector_type(8))) short;
using s16x4  = __attribute__((ext_vector_type(4))) short;
using f32x16 = __attribute__((ext_vector_type(16))) float;
using u32x4  = __attribute__((ext_vector_type(4))) unsigned;
using u32x2  = __attribute__((ext_vector_type(2))) unsigned;
constexpr int D = 128, NW = 8, QBLK = 32, KVBLK = 64, SEQ = 8192, LDK = 1024;
constexpr size_t SHM_V = KVBLK * D * 2, SHM_K = KVBLK * D * 2, SHM_ATTN = 2 * SHM_V + 2 * SHM_K + NW * 64 * 4;
#define KSWZ(row, colB) ((row) * 256 + ((colB) ^ (((row) & 7) << 4)))
#define SBAR() __builtin_amdgcn_sched_barrier(0)
__device__ __forceinline__ int crow(int r, int hi) { return (r & 3) + 8 * (r >> 2) + 4 * hi; }
__device__ __forceinline__ constexpr int crow0(int r) { return (r & 3) + 8 * (r >> 2); }
typedef float cvt_f32x2_t __attribute__((ext_vector_type(2))); typedef __bf16 cvt_bf16x2_t __attribute__((ext_vector_type(2)));
__device__ __forceinline__ unsigned cvtpk(float lo, float hi) { cvt_f32x2_t v = {lo, hi}; cvt_bf16x2_t b = __builtin_convertvector(v, cvt_bf16x2_t); return __builtin_bit_cast(unsigned, b); }
__device__ __forceinline__ float bf2f(bf16 x) { return __uint_as_float((unsigned)x << 16); }
__device__ __forceinline__ bf16x8 ld8(const bf16* p) { return *reinterpret_cast<const bf16x8*>(p); }
#define ATT_PK4(P, BASE, OUT) do { unsigned a0 = cvtpk(P[BASE + 0], P[BASE + 1]), a1 = cvtpk(P[BASE + 2], P[BASE + 3]);   \
    unsigned b0 = cvtpk(P[BASE + 4], P[BASE + 5]), b1 = cvtpk(P[BASE + 6], P[BASE + 7]);                              \
    auto r0 = __builtin_amdgcn_permlane32_swap(a0, b0, false, false); auto r1 = __builtin_amdgcn_permlane32_swap(a1, b1, false, false); \
    u32x4 w = {r0[0], r1[0], r0[1], r1[1]}; OUT = *reinterpret_cast<bf16x8*>(&w); } while (0)
__device__ __forceinline__ void pack_p(const f32x16& p0, const f32x16& p1, bf16x8& pa0, bf16x8& pa1, bf16x8& pa2, bf16x8& pa3) {
  ATT_PK4(p0, 0, pa0); ATT_PK4(p0, 8, pa1); ATT_PK4(p1, 0, pa2); ATT_PK4(p1, 8, pa3);
}
__device__ __forceinline__ void qkt(f32x16& p0, f32x16& p1, const bf16* Ks, const bf16x8* qr, int r32, int hi) {
  p0 = f32x16{}; p1 = f32x16{};
#pragma unroll
  for (int d0 = 0; d0 < 8; ++d0) { int cb = (d0 * 16 + hi * 8) * 2;
    bf16x8 b0 = *reinterpret_cast<const bf16x8*>((const char*)Ks + KSWZ(r32, cb));
    bf16x8 b1 = *reinterpret_cast<const bf16x8*>((const char*)Ks + KSWZ(32 + r32, cb));
    p0 = __builtin_amdgcn_mfma_f32_32x32x16_bf16(b0, qr[d0], p0, 0, 0, 0);
    p1 = __builtin_amdgcn_mfma_f32_32x32x16_bf16(b1, qr[d0], p1, 0, 0, 0); }
}
__device__ __forceinline__ int v_st(int k, int c) { const int kk = (k & ~0xC) | ((k & 4) << 1) | ((k & 8) >> 1); return ((kk >> 3) * 4 + (c >> 5)) * 512 + ((kk & 7) * 32 + (c & 31)) * 2; }
__device__ __forceinline__ int v_rd_base(int lane) { return ((lane & 3) << 3) | (((lane >> 2) & 3) << 6) | (((lane >> 4) & 1) << 5) | (((lane >> 5) & 1) << 8); }
constexpr int v_rd_off(int d0, int ks, int half) { return d0 * 512 + ks * 4096 + half * 2048; }
template <int OFF> __device__ __forceinline__ s16x4 tr_read(int vb) {
  s16x4 r; asm volatile("ds_read_b64_tr_b16 %0, %1 offset:%2" : "=&v"(r) : "v"(vb), "i"(OFF) : "memory"); return r;
}
template <int D0> __device__ __forceinline__ void pv_one(f32x16& od, int vb, bf16x8 pa0, bf16x8 pa1, bf16x8 pa2, bf16x8 pa3) {
  const s16x4 l0 = tr_read<v_rd_off(D0, 0, 0)>(vb), h0 = tr_read<v_rd_off(D0, 0, 1)>(vb), l1 = tr_read<v_rd_off(D0, 1, 0)>(vb), h1 = tr_read<v_rd_off(D0, 1, 1)>(vb);
  const s16x4 l2 = tr_read<v_rd_off(D0, 2, 0)>(vb), h2 = tr_read<v_rd_off(D0, 2, 1)>(vb), l3 = tr_read<v_rd_off(D0, 3, 0)>(vb), h3 = tr_read<v_rd_off(D0, 3, 1)>(vb);
  asm volatile("s_waitcnt lgkmcnt(0)" ::: "memory"); SBAR();
#define ATT_PK(L, H) (bf16x8){L[0], L[1], L[2], L[3], H[0], H[1], H[2], H[3]}
  od = __builtin_amdgcn_mfma_f32_32x32x16_bf16(pa0, ATT_PK(l0, h0), od, 0, 0, 0);
  od = __builtin_amdgcn_mfma_f32_32x32x16_bf16(pa1, ATT_PK(l1, h1), od, 0, 0, 0);
  od = __builtin_amdgcn_mfma_f32_32x32x16_bf16(pa2, ATT_PK(l2, h2), od, 0, 0, 0);
  od = __builtin_amdgcn_mfma_f32_32x32x16_bf16(pa3, ATT_PK(l3, h3), od, 0, 0, 0);
#undef ATT_PK
}
__device__ __forceinline__ void pv_d0(f32x16* o, int vb, bf16x8 pa0, bf16x8 pa1, bf16x8 pa2, bf16x8 pa3) {
  pv_one<0>(o[0], vb, pa0, pa1, pa2, pa3); pv_one<1>(o[1], vb, pa0, pa1, pa2, pa3); pv_one<2>(o[2], vb, pa0, pa1, pa2, pa3); pv_one<3>(o[3], vb, pa0, pa1, pa2, pa3);
}
__device__ __forceinline__ void store_act(const f32x16* o, const float* rli, bf16* Ow, const bf16* Zw, int r32, int hi) {
  int lbase = 4 * hi * LDK + r32; asm volatile("" : "+v"(lbase));
#pragma unroll
  for (int r = 0; r < 16; ++r) { const int off = crow0(r) * LDK + lbase;
    const float z0 = bf2f(Zw[off]), z1 = bf2f(Zw[off + 32]), z2 = bf2f(Zw[off + 64]), z3 = bf2f(Zw[off + 96]);
    const float v0 = o[0][r] * rli[r] * z0, v1 = o[1][r] * rli[r] * z1, v2 = o[2][r] * rli[r] * z2, v3 = o[3][r] * rli[r] * z3;
    Ow[off] = (bf16)(cvtpk(v0, v0) & 0xffffu); Ow[off + 32] = (bf16)(cvtpk(v1, v1) & 0xffffu); Ow[off + 64] = (bf16)(cvtpk(v2, v2) & 0xffffu); Ow[off + 96] = (bf16)(cvtpk(v3, v3) & 0xffffu);
    if (r & 1) asm volatile("" ::: "memory"); }
}

__device__ __forceinline__ void sb_unit(int b, int h, int qb, bf16* Q, const bf16* __restrict__ K, const bf16* __restrict__ V, const bf16* __restrict__ Zs, char* lds) {
  const int tid = threadIdx.x, wid = tid >> 6, lane = tid & 63, r32 = lane & 31, hi = lane >> 5;
  bf16* V_lds = (bf16*)lds; bf16* K_lds = (bf16*)(lds + SHM_V); int* flags = (int*)(lds + SHM_V + SHM_K);
  const long rowbase = (long)b * SEQ; const int t0 = qb * 256 + wid * 32, tq = t0 + r32;
  bf16x8 qr[8];
  { const bf16* Qw = Q + (rowbase + tq) * LDK + h * D + hi * 8;
#pragma unroll
    for (int d0 = 0; d0 < 8; ++d0) qr[d0] = ld8(Qw + d0 * 16); }
  const bf16* Kh = K + rowbase * LDK + h * D; const bf16* Vh = V + rowbase * LDK + h * D;
  const int sr = tid >> 4, sc = (tid & 15) * 8, vst0 = v_st(sr, sc), vst1 = v_st(32 + sr, sc);
  const int vb0 = (int)(uintptr_t)V_lds + v_rd_base(lane);
  f32x16 o[4] = {}; float carry = 0.f; bool done = false;
  const int NT = 4 * qb + 4, jw = 4 * qb + (wid >> 1);
  bf16x8 vs0, vs1, ks0, ks1;
#define SB_LOAD(k0) do { vs0 = ld8(&Vh[(long)((k0) + sr) * LDK + sc]); vs1 = ld8(&Vh[(long)((k0) + 32 + sr) * LDK + sc]); \
    ks0 = ld8(&Kh[(long)((k0) + sr) * LDK + sc]); ks1 = ld8(&Kh[(long)((k0) + 32 + sr) * LDK + sc]); } while (0)
  SB_LOAD((NT - 1) * KVBLK);
  for (int j = NT - 1; j >= 0; --j) {
    *(bf16x8*)((char*)V_lds + vst0) = vs0; *(bf16x8*)((char*)V_lds + vst1) = vs1;
    *(bf16x8*)((char*)K_lds + KSWZ(sr, sc * 2)) = ks0; *(bf16x8*)((char*)K_lds + KSWZ(32 + sr, sc * 2)) = ks1;
    __syncthreads();
    if (j > 0) SB_LOAD((j - 1) * KVBLK);
    if (j <= jw && !done) {
      f32x16 p0, p1; qkt(p0, p1, K_lds, qr, r32, hi);
      const bool diag = (j == jw); const int srel = tq - 64 * j - 4 * hi;
      const float fsel = hi ? 0.f : 1.f; float run = 0.f;
      { float L1[16];
#pragma unroll
        for (int r = 0; r < 16; ++r) { const float z = p1[r]; const float e = __builtin_amdgcn_exp2f(-__builtin_fabsf(z)); float L = -(__builtin_fmaxf(z, 0.f) + __builtin_amdgcn_logf(1.0f + e));
          if (diag && !(crow0(r) + 32 < srel)) L = 0.f; L1[r] = L; }
        float bb[4], pb[4], base1[4];
#pragma unroll
        for (int g = 0; g < 4; ++g) bb[g] = (L1[4 * g] + L1[4 * g + 1]) + (L1[4 * g + 2] + L1[4 * g + 3]);
#pragma unroll
        for (int g = 0; g < 4; ++g) pb[g] = __shfl_xor(bb[g], 32);
#pragma unroll
        for (int g = 3; g >= 0; --g) { base1[g] = run + fsel * pb[g]; run += bb[g] + pb[g]; }
#pragma unroll
        for (int g = 0; g < 4; ++g) { float s1 = carry + base1[g];
#pragma unroll
          for (int i = 3; i >= 0; --i) { const int r = 4 * g + i; s1 += L1[r]; float w1 = __builtin_amdgcn_exp2f(p1[r] + s1); if (diag && !(crow0(r) + 32 < srel)) w1 = 0.f; p1[r] = w1; } }
      }
      SBAR();
      { float L0[16];
#pragma unroll
        for (int r = 0; r < 16; ++r) { const float z = p0[r]; const float e = __builtin_amdgcn_exp2f(-__builtin_fabsf(z)); float L = -(__builtin_fmaxf(z, 0.f) + __builtin_amdgcn_logf(1.0f + e));
          if (diag && !(crow0(r) < srel)) L = 0.f; L0[r] = L; }
        float a[4], pa[4], base0[4];
#pragma unroll
        for (int g = 0; g < 4; ++g) a[g] = (L0[4 * g] + L0[4 * g + 1]) + (L0[4 * g + 2] + L0[4 * g + 3]);
#pragma unroll
        for (int g = 0; g < 4; ++g) pa[g] = __shfl_xor(a[g], 32);
#pragma unroll
        for (int g = 3; g >= 0; --g) { base0[g] = run + fsel * pa[g]; run += a[g] + pa[g]; }
#pragma unroll
        for (int g = 0; g < 4; ++g) { float s0 = carry + base0[g];
#pragma unroll
          for (int i = 3; i >= 0; --i) { const int r = 4 * g + i; s0 += L0[r]; float w0 = __builtin_amdgcn_exp2f(p0[r] + s0); if (diag && !(crow0(r) < srel)) w0 = 0.f; p0[r] = w0; } }
      }
      carry += run;
      bf16x8 pa0, pa1, pa2, pa3; pack_p(p0, p1, pa0, pa1, pa2, pa3);
      SBAR(); pv_d0(o, vb0, pa0, pa1, pa2, pa3);
      done = __all(carry < -160.f);
    }
    if (lane == 0) flags[wid] = done ? 1 : 0;
    __syncthreads();
    const int alld = flags[0] & flags[1] & flags[2] & flags[3] & flags[4] & flags[5] & flags[6] & flags[7];
    if (alld) break;
  }
#undef SB_LOAD
  float rli[16];
#pragma unroll
  for (int r = 0; r < 16; ++r) rli[r] = 1.0f;
  store_act(o, rli, Q + (rowbase + t0) * LDK + h * D, Zs + (rowbase + t0) * LDK + h * D, r32, hi);
  __syncthreads();
}

constexpr float THR2 = 11.5f;
__device__ __forceinline__ void sa_partial(f32x16& p0, f32x16& p1, float& m_reg, float& mn, float& alpha, u32x2 mw, float dbase, float nslope2, int hi) {
  const unsigned mx = mw.x >> (4 * hi), my = mw.y >> (4 * hi);
#pragma unroll
  for (int r = 0; r < 16; ++r) {
    const float d0 = dbase - (float)crow0(r), d1 = dbase - (float)(crow0(r) + 32);
    float x0 = __builtin_fmaf(__builtin_fabsf(d0), nslope2, p0[r]), x1 = __builtin_fmaf(__builtin_fabsf(d1), nslope2, p1[r]);
    const int s0 = ((int)(mx << (31 - crow0(r)))) >> 31, s1 = ((int)(my << (31 - crow0(r)))) >> 31;
    p0[r] = __int_as_float((__float_as_int(x0) & s0) | (~s0 & (int)0xff800000));
    p1[r] = __int_as_float((__float_as_int(x1) & s1) | (~s1 & (int)0xff800000));
  }
  float pmax = p0[0];
#pragma unroll
  for (int r = 1; r < 16; ++r) pmax = fmaxf(pmax, p0[r]);
#pragma unroll
  for (int r = 0; r < 16; ++r) pmax = fmaxf(pmax, p1[r]);
  { auto rr = __builtin_amdgcn_permlane32_swap(__float_as_uint(pmax), __float_as_uint(pmax), false, false);
    pmax = fmaxf(__uint_as_float(rr[0]), __uint_as_float(rr[1])); }
  if (__builtin_expect(__all(pmax - m_reg <= THR2), 1)) { mn = m_reg; alpha = 1.f; }
  else { mn = fmaxf(m_reg, pmax); alpha = __builtin_amdgcn_exp2f(m_reg - mn); m_reg = mn; }
#pragma unroll
  for (int r = 0; r < 16; ++r) { p0[r] = p0[r] - mn; p1[r] = p1[r] - mn; }
#pragma unroll
  for (int r = 0; r < 16; ++r) p0[r] = __builtin_amdgcn_exp2f(p0[r]);
}
__device__ __forceinline__ void sa_finish(f32x16& p0, f32x16& p1, float alpha, float& l_reg, bf16x8& pa0, bf16x8& pa1, bf16x8& pa2, bf16x8& pa3) {
#pragma unroll
  for (int r = 0; r < 16; ++r) p1[r] = __builtin_amdgcn_exp2f(p1[r]);
  float ps = 0;
#pragma unroll
  for (int r = 0; r < 16; ++r) ps += p0[r];
#pragma unroll
  for (int r = 0; r < 16; ++r) ps += p1[r];
  { auto rr = __builtin_amdgcn_permlane32_swap(__float_as_uint(ps), __float_as_uint(ps), false, false);
    ps = __uint_as_float(rr[0]) + __uint_as_float(rr[1]); }
  l_reg = l_reg * alpha + ps;
  pack_p(p0, p1, pa0, pa1, pa2, pa3);
}
__device__ __forceinline__ void sa_unit(int b, int h, int qb, bf16* Q, const bf16* __restrict__ K, const bf16* __restrict__ V, const bf16* __restrict__ Zs,
                                        const u32x2* __restrict__ maskp, char* lds) {
  const int tid = threadIdx.x, wid = tid >> 6, lane = tid & 63, r32 = lane & 31, hi = lane >> 5;
  bf16* V_lds = (bf16*)lds; bf16* K_lds = (bf16*)(lds + 2 * SHM_V);
  float* ws = (float*)(lds + 2 * SHM_V + 2 * SHM_K) + wid * 64; float* li_l = ws; float* al_l = ws + 32;
  const long rowbase = (long)b * SEQ; const int t0 = qb * 256 + wid * 32, tq = t0 + r32;
  float m_reg = -1e30f, l_reg = 0; f32x16 o[4] = {}; bf16x8 qr[8];
  { const bf16* Qw = Q + (rowbase + tq) * LDK + h * D + hi * 8;
#pragma unroll
    for (int d0 = 0; d0 < 8; ++d0) qr[d0] = ld8(Qw + d0 * 16); }
  const bf16* Kh = K + rowbase * LDK + h * D; const bf16* Vh = V + rowbase * LDK + h * D;
  const u32x2* mrow = maskp + (rowbase + tq) * 128;
  const float nslope2 = -1.4426950408889634f * __builtin_amdgcn_exp2f(-(float)(h + 1));
  const int sr = tid >> 4, sc = (tid & 15) * 8, vst0 = v_st(sr, sc), vst1 = v_st(32 + sr, sc);
  const int vb0 = (int)(uintptr_t)V_lds + v_rd_base(lane);
  struct { bf16x8 vs0, vs1, ks0, ks1; } sr_[1];
  const int NT = 4 * qb + 4;
#define KOF(i) ((NT - 1 - (i)) * KVBLK)
#define DBASE(i) ((float)(tq - KOF(i) - 4 * hi))
#define SLOAD(i, k0) do { sr_[i].vs0 = ld8(&Vh[(long)((k0) + sr) * LDK + sc]); sr_[i].vs1 = ld8(&Vh[(long)((k0) + 32 + sr) * LDK + sc]); \
    sr_[i].ks0 = ld8(&Kh[(long)((k0) + sr) * LDK + sc]); sr_[i].ks1 = ld8(&Kh[(long)((k0) + 32 + sr) * LDK + sc]); } while (0)
#define SWRITE(bf, i) do { *(bf16x8*)((char*)V_lds + (bf) * SHM_V + vst0) = sr_[i].vs0;          \
    *(bf16x8*)((char*)V_lds + (bf) * SHM_V + vst1) = sr_[i].vs1; int kc = sc * 2;               \
    *(bf16x8*)((char*)K_lds + (bf) * SHM_K + KSWZ(sr, kc)) = sr_[i].ks0;                       \
    *(bf16x8*)((char*)K_lds + (bf) * SHM_K + KSWZ(32 + sr, kc)) = sr_[i].ks1; } while (0)
#define SWAIT() asm volatile("s_waitcnt vmcnt(0)" ::: "memory")
#define RESC(a) do { if (__any((a) < 1.f)) { if (hi == 0) al_l[r32] = (a); asm volatile("s_waitcnt lgkmcnt(0)" ::: "memory"); \
    _Pragma("unroll") for (int d = 0; d < 4; ++d) _Pragma("unroll") for (int r = 0; r < 16; ++r) o[d][r] *= al_l[crow(r, hi)]; } } while (0)
  f32x16 pA0, pA1, pB0, pB1; float mnA, mnB, alA, alB; bf16x8 pa0, pa1, pa2, pa3;
  constexpr int SE = 0, SO = 0;
  u32x2 mwA = mrow[NT - 1], mwB;
  SLOAD(SE, KOF(0)); asm volatile("s_waitcnt vmcnt(0)" ::: "memory"); SWRITE(0, SE); __syncthreads();
  qkt(pA0, pA1, K_lds, qr, r32, hi); sa_partial(pA0, pA1, m_reg, mnA, alA, mwA, DBASE(0), nslope2, hi);
  SLOAD(SO, KOF(1));
  SWAIT(); SWRITE(1, SO); __syncthreads();
  for (int j = 1; j + 1 < NT; j += 2) {
    mwB = mrow[NT - 1 - j];
    SBAR(); qkt(pB0, pB1, (bf16*)((char*)K_lds + SHM_K), qr, r32, hi);
    sa_finish(pA0, pA1, alA, l_reg, pa0, pa1, pa2, pa3); SBAR();
    SLOAD(SE, KOF(j + 1)); SBAR();
    pv_d0(o, vb0, pa0, pa1, pa2, pa3); sa_partial(pB0, pB1, m_reg, mnB, alB, mwB, DBASE(j), nslope2, hi);
    __syncthreads(); SWAIT(); SWRITE(0, SE);
    RESC(alB); __syncthreads();
    mwA = mrow[NT - 2 - j];
    SBAR(); qkt(pA0, pA1, K_lds, qr, r32, hi);
    sa_finish(pB0, pB1, alB, l_reg, pa0, pa1, pa2, pa3); SBAR();
    SLOAD(SO, KOF(j + 2)); SBAR();
    pv_d0(o, vb0 + (int)SHM_V, pa0, pa1, pa2, pa3); sa_partial(pA0, pA1, m_reg, mnA, alA, mwA, DBASE(j + 1), nslope2, hi);
    __syncthreads(); SWAIT(); SWRITE(1, SO);
    RESC(alA); __syncthreads();
  }
  mwB = mrow[0];
  SBAR(); qkt(pB0, pB1, (bf16*)((char*)K_lds + SHM_K), qr, r32, hi);
  sa_finish(pA0, pA1, alA, l_reg, pa0, pa1, pa2, pa3); SBAR();
  pv_d0(o, vb0, pa0, pa1, pa2, pa3); sa_partial(pB0, pB1, m_reg, mnB, alB, mwB, DBASE(NT - 1), nslope2, hi);
  __syncthreads(); RESC(alB);
  sa_finish(pB0, pB1, alB, l_reg, pa0, pa1, pa2, pa3); SBAR();
  pv_d0(o, vb0 + (int)SHM_V, pa0, pa1, pa2, pa3);
  if (hi == 0) li_l[r32] = l_reg; asm volatile("s_waitcnt lgkmcnt(0)" ::: "memory");
  float rli[16];
#pragma unroll
  for (int r = 0; r < 16; ++r) rli[r] = __builtin_amdgcn_rcpf(li_l[crow(r, hi)]);
  store_act(o, rli, Q + (rowbase + t0) * LDK + h * D, Zs + (rowbase + t0) * LDK + h * D, r32, hi);
  __syncthreads();
#undef KOF
#undef DBASE
#undef SLOAD
#undef SWRITE
#undef SWAIT
#undef RESC
}
#undef KSWZ
#undef SBAR
}

namespace idx {
typedef unsigned short bf16;
using bf16x8 = __attribute__((ext_vector_type(8))) short;
using f32x4  = __attribute__((ext_vector_type(4))) float;
using u32x4  = __attribute__((ext_vector_type(4))) unsigned;
using u32x2  = __attribute__((ext_vector_type(2))) unsigned;
constexpr int SEQ = 8192;
__device__ __forceinline__ float bf2f(short x) { return __uint_as_float(((unsigned)(unsigned short)x) << 16); }
typedef float cvt_f32x2_t __attribute__((ext_vector_type(2))); typedef __bf16 cvt_bf16x2_t __attribute__((ext_vector_type(2)));
__device__ __forceinline__ unsigned cvtpk(float lo, float hi) { cvt_f32x2_t v = {lo, hi}; cvt_bf16x2_t b = __builtin_convertvector(v, cvt_bf16x2_t); return __builtin_bit_cast(unsigned, b); }
__device__ __forceinline__ unsigned monokey(float s) { const unsigned u = __float_as_uint(s); return u ^ ((unsigned)((int)u >> 31) | 0x80000000u); }

#define IDX_SCORE(sc, ka0, ka1) do { \
    sc = __builtin_amdgcn_mfma_f32_16x16x32_bf16(ka0, qlin0, (f32x4){0.f, 0.f, 0.f, 0.f}, 0, 0, 0); sc = __builtin_amdgcn_mfma_f32_16x16x32_bf16(ka1, qlin1, sc, 0, 0, 0); \
    _Pragma("unroll") for (int h_ = 0; h_ < 16; ++h_) { \
      f32x4 x_ = __builtin_amdgcn_mfma_f32_16x16x32_bf16(ka0, q[h_][0], (f32x4){0.f, 0.f, 0.f, 0.f}, 0, 0, 0); x_ = __builtin_amdgcn_mfma_f32_16x16x32_bf16(ka1, q[h_][1], x_, 0, 0, 0); \
      sc[0] = __builtin_fmaf(__builtin_fabsf(x_[0]), wh[h_], sc[0]); sc[1] = __builtin_fmaf(__builtin_fabsf(x_[1]), wh[h_], sc[1]); \
      sc[2] = __builtin_fmaf(__builtin_fabsf(x_[2]), wh[h_], sc[2]); sc[3] = __builtin_fmaf(__builtin_fabsf(x_[3]), wh[h_], sc[3]); \
      __builtin_amdgcn_sched_barrier(0); } } while (0)

__device__ __forceinline__ void idx_unit(int b, int c, int hf, const bf16* __restrict__ Qidx, const bf16* __restrict__ kidx, const float* __restrict__ widx, u32x2* maskp, char* lds) {
  const int tid = threadIdx.x, wid = tid >> 6, lane = tid & 63, g = wid & 1, kq = wid >> 1, qi = lane & 15, kg = lane >> 4;
  const int t = 64 * c + 32 * hf + 16 * g + qi; const long rowg = (long)b * SEQ + t;
  const int NT = c + 1;
  unsigned* cntbuf = (unsigned*)lds;
  bf16x8 q[16][2]; float wh[16];
#pragma unroll
  for (int h = 0; h < 16; ++h) {
    q[h][0] = *reinterpret_cast<const bf16x8*>(Qidx + rowg * 1024 + h * 64 + kg * 8);
    q[h][1] = *reinterpret_cast<const bf16x8*>(Qidx + rowg * 1024 + h * 64 + 32 + kg * 8);
    wh[h] = 0.5f * widx[rowg * 16 + h];
  }
  bf16x8 qlin0, qlin1;
  { float l0[8], l1[8];
#pragma unroll
    for (int e = 0; e < 8; ++e) { l0[e] = 0.f; l1[e] = 0.f; }
#pragma unroll
    for (int h = 0; h < 16; ++h)
#pragma unroll
      for (int e = 0; e < 8; ++e) { l0[e] = __builtin_fmaf(wh[h], bf2f(q[h][0][e]), l0[e]); l1[e] = __builtin_fmaf(wh[h], bf2f(q[h][1][e]), l1[e]); }
    u32x4 w0 = {cvtpk(l0[0], l0[1]), cvtpk(l0[2], l0[3]), cvtpk(l0[4], l0[5]), cvtpk(l0[6], l0[7])};
    u32x4 w1 = {cvtpk(l1[0], l1[1]), cvtpk(l1[2], l1[3]), cvtpk(l1[4], l1[5]), cvtpk(l1[6], l1[7])};
    qlin0 = *reinterpret_cast<bf16x8*>(&w0); qlin1 = *reinterpret_cast<bf16x8*>(&w1); }
  const bf16* kbase = kidx + ((long)b * SEQ + qi) * 64 + kg * 8;
  unsigned T = 0u;
#pragma unroll 1
  for (int it = (NT > 4) ? 0 : 32; it <= 32; ++it) {
    const bool emit = (it == 32);
    const unsigned probe = emit ? T : (T | (0x80000000u >> it)); unsigned cnt = 0u, lo = 0u, hiw = 0u;
#pragma unroll 1
    for (int js = 4 * kq; js < 4 * NT; js += (js & 3) == 3 ? 13 : 1) {
      const bf16* kp = kbase + (long)(16 * js) * 64;
      const bf16x8 ka0 = *reinterpret_cast<const bf16x8*>(kp), ka1 = *reinterpret_cast<const bf16x8*>(kp + 32);
      f32x4 sc; IDX_SCORE(sc, ka0, ka1);
      unsigned bits = 0u;
#pragma unroll
      for (int r = 0; r < 4; ++r) bits |= (monokey(sc[r]) >= probe) ? (1u << r) : 0u;
      cnt += __builtin_popcount(bits);
      if (emit) {
        const int sub = js & 3; bits <<= (4 * kg + 16 * (sub & 1));
        if (sub < 2) lo |= bits; else hiw |= bits;
        if (sub == 3) {
          lo |= __shfl_xor(lo, 16); lo |= __shfl_xor(lo, 32); hiw |= __shfl_xor(hiw, 16); hiw |= __shfl_xor(hiw, 32);
          if (kg == 0) maskp[rowg * 128 + (js >> 2)] = (u32x2){lo, hiw};
          lo = 0u; hiw = 0u; }
      }
    }
    if (!emit) {
      cnt += __shfl_xor(cnt, 16); cnt += __shfl_xor(cnt, 32);
      if (kg == 0) cntbuf[(16 * g + qi) * 4 + kq] = cnt;
      __syncthreads();
      const u32x4 cc = *reinterpret_cast<const u32x4*>(cntbuf + (16 * g + qi) * 4);
      if (cc.x + cc.y + cc.z + cc.w >= 256u) T = probe;
      __syncthreads();
    }
  }
  if (kq == 0 && kg == 0) for (int j = NT; j <= (c | 3); ++j) maskp[rowg * 128 + j] = (u32x2){0u, 0u};
}
#undef IDX_SCORE
}

constexpr int NWAVES = 8;
#ifndef MK_N_LAUNCHES
#define MK_N_LAUNCHES 7
#endif
constexpr int N_PHASES = 7;
constexpr int N_LAUNCHES = MK_N_LAUNCHES;
static_assert(N_LAUNCHES == 1 || N_LAUNCHES == N_PHASES, "MK_N_LAUNCHES is 1 or 7");

constexpr int BATCH = 2, SEQ = 8192, DMODEL = 2048, M = BATCH * SEQ, BW = 1024  , NPACK = 13568  , NIN = 13392;
constexpr float RMS_EPS = 1e-6f;
constexpr float QSCALE = 0.08838834764831845f * 1.4426950408889634f;

constexpr size_t MiB = 1u << 20;
constexpr size_t WS_CTL = 0, CTL_ZERO_BYTES = 1 * MiB;
constexpr size_t WS_KIDX = 1 * MiB;
constexpr size_t WS_WIDX = 3 * MiB;
constexpr size_t WS_PSS  = 4 * MiB;
constexpr size_t WS_WSB  = 6 * MiB, WS_WSA = 10 * MiB, WS_WOUT = 14 * MiB;
constexpr size_t WS_MASK = 22 * MiB;
constexpr size_t WS_P9   = 38 * MiB;
constexpr size_t P9_STRIDE = (size_t)M * 1024 * 2;
constexpr size_t WS_G    = WS_P9 + 9 * P9_STRIDE;
constexpr size_t WS_END  = WS_G + (size_t)M * 4096 * 2;
constexpr size_t WS_T1   = WS_P9 + 1 * P9_STRIDE;
constexpr size_t WS_MIX  = WS_P9 + 5 * P9_STRIDE;
constexpr size_t OUT_WIN = 0, OUT_XN = 56 * MiB;
static_assert(OUT_XN >= (size_t)NPACK * DMODEL * 2 && OUT_XN + (size_t)M * DMODEL * 2 <= (size_t)M * DMODEL * 4, "d_out scratch map");
constexpr int CW_TMO = 0, CW_CODE = 1, CW_BAR = 4096;

constexpr int RING_OFF = 0, RING_BYTES = 131072;
constexpr int LDSCTL_OFF = RING_BYTES, MISC_OFF = LDSCTL_OFF + 320;
constexpr int LDS_BYTES = 147456;
static_assert(MISC_OFF + 128 <= LDS_BYTES, "LDS map");

#define GAS __attribute__((address_space(1)))
#define LAS __attribute__((address_space(3)))
typedef unsigned short bf16;
typedef unsigned v4u __attribute__((ext_vector_type(4)));
typedef float f32x4 __attribute__((ext_vector_type(4)));
typedef short bf16x8 __attribute__((ext_vector_type(8)));
typedef GAS unsigned gu32;
typedef GAS unsigned long long gu64;
#define RLX_AGENT __ATOMIC_RELAXED, __HIP_MEMORY_SCOPE_AGENT
#define LDS_WAIT() asm volatile("s_waitcnt lgkmcnt(0)" ::: "memory")
#define VM_WAIT() asm volatile("s_waitcnt vmcnt(0)" ::: "memory")
__device__ __forceinline__ unsigned long long rt() { return __builtin_amdgcn_s_memrealtime(); }
__device__ __forceinline__ unsigned f2bf(float f) { unsigned u = __builtin_bit_cast(unsigned, f); return (u + 0x7fffu + ((u >> 16) & 1u)) >> 16; }
__device__ __forceinline__ unsigned pk2(float lo, float hi) { return f2bf(lo) | (f2bf(hi) << 16); }
#define XB_TMO      128
#define XB_XCNT(j)  (256  + 64 * (j))
#define XB_XSUB(j)  (1280 + 64 * (j))
#define XB_XGEN(j)  (2304 + 64 * (j))
#define XB_TOP      3328
#define XB_TOPGEN   3392
#define XCD_BAR_WORDS 3456
#define XB_SPIN_CAP (1u << 22)

__device__ __forceinline__ unsigned xb_ld(unsigned* p)              { return __hip_atomic_load(p, __ATOMIC_RELAXED, __HIP_MEMORY_SCOPE_AGENT); }
__device__ __forceinline__ unsigned xb_add(unsigned* p, unsigned v) { return __hip_atomic_fetch_add(p, v, __ATOMIC_RELAXED, __HIP_MEMORY_SCOPE_AGENT); }
__device__ __forceinline__ unsigned xb_xcc_id() { return (unsigned)__builtin_amdgcn_s_getreg((3 << 11) | 20) & 0xFu; }
#define XB_SPIN(cond, bar) do { unsigned _sp = 0; while (cond) { __builtin_amdgcn_s_sleep(1); \
    if ((++_sp & 255u) == 0u) { if (xb_ld(&(bar)[XB_TMO])) break; if (_sp > XB_SPIN_CAP) { atomicAdd(&(bar)[XB_TMO], 1u); break; } } } } while (0)

struct XcdBarrier {
    unsigned* bar; unsigned x;
    volatile LAS unsigned* st;
};

__device__ __forceinline__ XcdBarrier xcd_barrier_post(unsigned* bar, volatile LAS unsigned* st) {
    XcdBarrier b; b.bar = bar; b.x = xb_xcc_id(); b.st = st;
    if (threadIdx.x == 0) (void)xb_add(&bar[XB_XCNT(b.x)], 1u);
    return b;
}
__device__ __forceinline__ void xcd_barrier_complete(unsigned* bar, unsigned x, unsigned& nloc, unsigned& nx) {
    const unsigned G = gridDim.x * gridDim.y * gridDim.z;
    unsigned sum, cnt, mine, sp = 0u;
    for (;;) {
        sum = 0u; cnt = 0u; mine = 0u;
#pragma unroll
        for (unsigned j = 0; j < 16; ++j) { const unsigned c = xb_ld(&bar[XB_XCNT(j)]); sum += c; cnt += (c > 0u) ? 1u : 0u; mine = (j == x) ? c : mine; }
        if (sum == G) break;
        __builtin_amdgcn_s_sleep(1);
        if ((++sp & 255u) == 0u) { if (xb_ld(&bar[XB_TMO])) break; if (sp > XB_SPIN_CAP) { atomicAdd(&bar[XB_TMO], 1u); break; } }
    }
    nloc = mine > 0u ? mine : 1u; nx = cnt > 0u ? cnt : 1u;
}

__device__ __forceinline__ void xcd_barrier(const XcdBarrier& b) {
    asm volatile("s_waitcnt vmcnt(0)" ::: "memory");
    __syncthreads();
    if (threadIdx.x == 0) {
        unsigned* bar = b.bar;
        __builtin_amdgcn_s_waitcnt(0);
        unsigned nloc = b.st[0], nx = b.st[1];
        if (nloc == 0u) { xcd_barrier_complete(bar, b.x, nloc, nx); b.st[0] = nloc; b.st[1] = nx; }
        const unsigned old = xb_add(&bar[XB_XSUB(b.x)], 1u);
        const unsigned gen = old / nloc;
        if (old + 1u == (gen + 1u) * nloc) {
            __builtin_amdgcn_fence(__ATOMIC_RELEASE, "agent");
            asm volatile("s_waitcnt vmcnt(0)" ::: "memory");
            const unsigned og = xb_add(&bar[XB_TOP], 1u);
            const unsigned tg = og / nx;
            if (og + 1u == (tg + 1u) * nx) xb_add(&bar[XB_TOPGEN], 1u);
            else XB_SPIN(xb_ld(&bar[XB_TOPGEN]) == tg, bar);
            __builtin_amdgcn_fence(__ATOMIC_ACQUIRE, "agent");
            xb_add(&bar[XB_XGEN(b.x)], 1u);
            asm volatile("s_waitcnt vmcnt(0)" ::: "memory");
        } else {
            XB_SPIN(xb_ld(&bar[XB_XGEN(b.x)]) == gen, bar);
            __builtin_amdgcn_fence(__ATOMIC_ACQUIRE, "agent");
            asm volatile("s_waitcnt vmcnt(0)" ::: "memory");
        }
    }
    __syncthreads();
}
struct Frame {
    LAS unsigned char* lds;
    volatile LAS unsigned* MISC;
    gu32* ctl;
    int tid, lane, wave;
    int vcu, G;
    const float *x, *gain, *w_in, *w_sb, *w_sa, *w_out, *fgain; float* out;
    unsigned char *ws, *outb;
};
__device__ __forceinline__ float wave_sum(float v) {
#pragma unroll
    for (int o = 1; o < 64; o <<= 1) v += __shfl_xor(v, o);
    return v;
}
template <class CMap>
__device__ __forceinline__ void p0_transpose_item(const float* W, int ldw, int K, bf16* WT, const float* rowgain, const CMap& cm, LAS float* scr, int kb, int nb, int lane) {
    const int k0 = 64 * kb, n0 = 32 * nb, n = n0 + (lane & 31); float sc; const int cs = cm(n, sc);
#pragma unroll 8
    for (int i = 0; i < 32; ++i) { const int kk = 2 * i + (lane >> 5); float v = 0.f;
        if (cs >= 0) { v = W[(size_t)(k0 + kk) * ldw + cs] * sc; if (rowgain) v *= rowgain[k0 + kk]; }
        scr[kk * 33 + (lane & 31)] = v; }
    LDS_WAIT(); asm volatile("" ::: "memory");
    const int c = lane & 7;
#pragma unroll
    for (int j = 0; j < 4; ++j) { const int nn = (lane >> 3) + 8 * j; const LAS float* s = scr + (8 * c) * 33 + nn;
        v4u o; o.x = pk2(s[0 * 33], s[1 * 33]); o.y = pk2(s[2 * 33], s[3 * 33]); o.z = pk2(s[4 * 33], s[5 * 33]); o.w = pk2(s[6 * 33], s[7 * 33]);
        *(GAS v4u*)(WT + (size_t)(n0 + nn) * K + k0 + 8 * c) = o; }
    LDS_WAIT(); asm volatile("" ::: "memory");
}
struct CMapWin {
    __device__ __forceinline__ int operator()(int n, float& sc) const {
        sc = 1.f;
        if (n < 9216) { if (n < 1024 || (n >= 4096 && n < 5120)) sc = QSCALE; else if (n >= 8192) sc = 0.125f; return n; }
        if (n < 13312) return n + 80;
        if (n < 13392) { if (n >= 13376) sc = 0.25f; return n - 13312 + 9216; }
        return -1;
    }
};
struct CMapId { __device__ __forceinline__ int operator()(int n, float& sc) const { sc = 1.f; return n; } };
__device__ __forceinline__ void rms_row_to_bf16(const float* xrow, bf16* orow, int lane) {
    const GAS f32x4* xr = (const GAS f32x4*)xrow + lane;
    f32x4 v[8]; float s = 0.f;
#pragma unroll
    for (int j = 0; j < 8; ++j) { v[j] = xr[64 * j]; s += (v[j].x * v[j].x + v[j].y * v[j].y) + (v[j].z * v[j].z + v[j].w * v[j].w); }
    const float rstd = 1.f / sqrtf(wave_sum(s) * (1.f / DMODEL) + RMS_EPS);
    GAS unsigned long long* o8 = (GAS unsigned long long*)orow + lane;
#pragma unroll
    for (int j = 0; j < 8; ++j) o8[64 * j] = (unsigned long long)pk2(v[j].x * rstd, v[j].y * rstd) | ((unsigned long long)pk2(v[j].z * rstd, v[j].w * rstd) << 32);
}
__device__ __forceinline__ void p0_prologue(Frame& F) {
    LAS float* scr = (LAS float*)(F.lds + RING_OFF + F.wave * 16384);
    const int gw = F.vcu * NWAVES + F.wave, NGW = F.G * NWAVES;
    constexpr int I_IN = (DMODEL / 64) * (NPACK / 32), I_B = (BW / 64) * (DMODEL / 32), I_O = (DMODEL / 64) * (DMODEL / 32);
    constexpr int NITEMS = I_IN + 2 * I_B + I_O;
    bf16* Win_t = (bf16*)(F.outb + OUT_WIN);
    for (int it = gw; it < NITEMS; it += NGW) {
        int r = it;
        if (r < I_IN) { p0_transpose_item(F.w_in, NIN, DMODEL, Win_t, F.gain, CMapWin{}, scr, r / (NPACK / 32), r % (NPACK / 32), F.lane); continue; } r -= I_IN;
        if (r < I_B) { p0_transpose_item(F.w_sb, DMODEL, BW, (bf16*)(F.ws + WS_WSB), nullptr, CMapId{}, scr, r / (DMODEL / 32), r % (DMODEL / 32), F.lane); continue; } r -= I_B;
        if (r < I_B) { p0_transpose_item(F.w_sa, DMODEL, BW, (bf16*)(F.ws + WS_WSA), nullptr, CMapId{}, scr, r / (DMODEL / 32), r % (DMODEL / 32), F.lane); continue; } r -= I_B;
        p0_transpose_item(F.w_out, DMODEL, DMODEL, (bf16*)(F.ws + WS_WOUT), nullptr, CMapId{}, scr, r / (DMODEL / 32), r % (DMODEL / 32), F.lane);
    }
    bf16* XN = (bf16*)(F.outb + OUT_XN);
    for (int m = gw; m < M; m += NGW) rms_row_to_bf16(F.x + (size_t)m * DMODEL, XN + (size_t)m * DMODEL, F.lane);
}
__device__ __forceinline__ void p6_final_norm(Frame& F) {
    const int gw = F.vcu * NWAVES + F.wave, NGW = F.G * NWAVES;
    const float* pss = (const float*)(F.ws + WS_PSS);
    f32x4 gv[8];
#pragma unroll
    for (int j = 0; j < 8; ++j) gv[j] = ((const GAS f32x4*)F.fgain)[F.lane + 64 * j];
    for (int m = gw; m < M; m += NGW) {
        const float part = (F.lane < 32) ? pss[(size_t)m * 32 + F.lane] : 0.f;
        const float rstd = 1.f / sqrtf(wave_sum(part) * (1.f / DMODEL) + RMS_EPS);
        GAS f32x4* hr = (GAS f32x4*)(F.out + (size_t)m * DMODEL) + F.lane;
#pragma unroll
        for (int j = 0; j < 8; ++j) { f32x4 v = hr[64 * j]; v = v * rstd * gv[j]; hr[64 * j] = v; }
    }
}

struct Args { const float* in[7]; float* out; unsigned char* ws; int ph_lo, ph_hi, li, pad; };
__global__ void __launch_bounds__(NWAVES * 64, 2) hsd_fwd(Args args) {
    extern __shared__ __attribute__((aligned(16))) unsigned char lds[];
    Frame F;
    F.lds = (LAS unsigned char*)lds;
    F.MISC = (volatile LAS unsigned*)(F.lds + MISC_OFF);
    F.tid = threadIdx.x; F.lane = F.tid & 63; F.wave = __builtin_amdgcn_readfirstlane(F.tid >> 6);
    F.G = gridDim.x; { const int bx = blockIdx.x; F.vcu = (F.G % 8 == 0) ? (bx % 8) * (F.G / 8) + bx / 8 : bx; }
    F.ws = args.ws; F.outb = (unsigned char*)args.out; F.out = args.out;
    F.ctl = (gu32*)(F.ws + WS_CTL);
    F.x = args.in[0]; F.gain = args.in[1]; F.w_in = args.in[2]; F.w_sb = args.in[3]; F.w_sa = args.in[4]; F.w_out = args.in[5]; F.fgain = args.in[6];
    for (int u = F.tid; u < (LDS_BYTES - LDSCTL_OFF) / 4; u += NWAVES * 64) ((LAS unsigned*)(F.lds + LDSCTL_OFF))[u] = 0u;
    __syncthreads();
    XcdBarrier bar; bar.bar = (unsigned*)(F.ctl + CW_BAR); bar.x = 0; bar.st = nullptr;
    if (N_LAUNCHES == 1) bar = xcd_barrier_post((unsigned*)(F.ctl + CW_BAR), F.MISC + 8);
#define GRID_BAR() do { if (N_LAUNCHES == 1) { xcd_barrier(bar); } } while (0)
    const int lo = args.ph_lo, hi = args.ph_hi;
#ifndef PHASE_MASK
#define PHASE_MASK 0x7f
#endif
#define IN(k) ((((PHASE_MASK) >> (k)) & 1) && lo <= (k) && (k) < hi)
#define BOTH(k) (IN(k) && IN((k) + 1))
    bf16* P9 = (bf16*)(F.ws + WS_P9);
    bf16* Gt = (bf16*)(F.ws + WS_G);
    const size_t PS = (size_t)M * 1024;

    if (IN(0)) { p0_prologue(F); if (BOTH(0)) GRID_BAR(); }

    if (IN(1)) {
        pg8::Gemm g{(const bf16*)(F.outb + OUT_XN), (const bf16*)(F.outb + OUT_WIN), M, NPACK, DMODEL}; pg8::StaticOrder S; S.init(M, NPACK, F.G, (int)blockIdx.x);
        pg8::EpiProj E{P9, Gt, (bf16*)(F.ws + WS_KIDX), (float*)(F.ws + WS_WIDX)};
        pg8::gemm_phase<pg8::EpiProj, pg8::StaticOrder, true, true>(F.lds + RING_OFF, g, S, E);
        if (BOTH(1)) GRID_BAR();
    }

    if (IN(2)) {
#ifndef NO_IDX
        for (int v2 = F.vcu; v2 < 512; v2 += F.G) { const int v = v2 & 255, b = (v >> 7) & 1, p = (v & 127) >> 1, hf = v & 1, c = (v2 < 256) ? p : 127 - p;
            idx::idx_unit(b, c, hf, P9 + 8 * PS, (const bf16*)(F.ws + WS_KIDX), (const float*)(F.ws + WS_WIDX), (idx::u32x2*)(F.ws + WS_MASK), (char*)lds + RING_OFF);
            __syncthreads(); }
#endif
#ifndef NO_SB
        for (int u = F.vcu; u < 512; u += F.G) { const int b = u >> 8, h = (u >> 5) & 7, qb = u & 31;
            att::sb_unit(b, h, qb, P9 + 0 * PS, P9 + 1 * PS, P9 + 2 * PS, P9 + 3 * PS, (char*)lds + RING_OFF); }
#endif
        if (BOTH(2)) GRID_BAR();
    }

    if (IN(3)) {
        for (int u = F.vcu; u < 256; u += F.G) { const int bh = u >> 4, s = u & 15, b = bh >> 3, h = bh & 7;
            att::sa_unit(b, h, 31 - s, P9 + 4 * PS, P9 + 5 * PS, P9 + 6 * PS, P9 + 7 * PS, (const att::u32x2*)(F.ws + WS_MASK), (char*)lds + RING_OFF);
            att::sa_unit(b, h, s, P9 + 4 * PS, P9 + 5 * PS, P9 + 6 * PS, P9 + 7 * PS, (const att::u32x2*)(F.ws + WS_MASK), (char*)lds + RING_OFF); }
        if (BOTH(3)) GRID_BAR();
    }

    if (IN(4)) {
        pg8::StaticOrder S; S.init(M, DMODEL, F.G, (int)blockIdx.x);
        { pg8::Gemm g{P9 + 0 * PS, (const bf16*)(F.ws + WS_WSB), M, DMODEL, BW};
          pg8::EpiGate<0> E{Gt, 0, nullptr, (bf16*)(F.ws + WS_T1)};
          pg8::gemm_phase<pg8::EpiGate<0>, pg8::StaticOrder, true, true>(F.lds + RING_OFF, g, S, E); }
        { pg8::Gemm g{P9 + 4 * PS, (const bf16*)(F.ws + WS_WSA), M, DMODEL, BW};
          pg8::EpiGate<1> E{Gt, 2048, (const bf16*)(F.ws + WS_T1), (bf16*)(F.ws + WS_MIX)};
          pg8::gemm_phase<pg8::EpiGate<1>, pg8::StaticOrder, true, true>(F.lds + RING_OFF, g, S, E); }
        if (BOTH(4)) GRID_BAR();
    }

    if (IN(5)) {
        pg8::Gemm g{(const bf16*)(F.ws + WS_MIX), (const bf16*)(F.ws + WS_WOUT), M, DMODEL, DMODEL}; pg8::StaticOrder S; S.init(M, DMODEL, F.G, (int)blockIdx.x);
        pg8::EpiOut E{F.x, F.out, (float*)(F.ws + WS_PSS)};
        pg8::gemm_phase<pg8::EpiOut, pg8::StaticOrder, true, true>(F.lds + RING_OFF, g, S, E);
        if (BOTH(5)) GRID_BAR();
    }

    if (IN(6)) { p6_final_norm(F); }
#undef IN
#undef BOTH
#undef GRID_BAR
}

extern "C" void kernel_launch(void* const* d_in, const int* in_sizes, int n_in, void* d_out, int out_size, void* d_ws, size_t ws_size, hipStream_t stream) {
    static int grid = 0;
    if (grid == 0) {
        if (n_in != 7 || in_sizes[0] != M * DMODEL || out_size != M * DMODEL || ws_size < WS_END) {
            fprintf(stderr, "kernel_launch: built for 7 inputs, x and out of %d floats, >= %zu bytes of workspace; got n_in %d, in0 %d, out %d, ws %zu; nothing launched\n", M * DMODEL, (size_t)WS_END, n_in, n_in > 0 ? in_sizes[0] : -1, out_size, ws_size); grid = -1; return; }
        int dev = 0, cus = 0, per_cu = 0;
        if (hipGetDevice(&dev) != hipSuccess || hipDeviceGetAttribute(&cus, hipDeviceAttributeMultiprocessorCount, dev) != hipSuccess) { fprintf(stderr, "kernel_launch: device query failed\n"); grid = -1; return; }
        if (hipFuncSetAttribute((const void*)hsd_fwd, hipFuncAttributeMaxDynamicSharedMemorySize, LDS_BYTES) != hipSuccess) { fprintf(stderr, "kernel_launch: hipFuncSetAttribute failed\n"); grid = -1; return; }
        if (hipOccupancyMaxActiveBlocksPerMultiprocessor(&per_cu, (const void*)hsd_fwd, NWAVES * 64, LDS_BYTES) != hipSuccess || per_cu < 1)
            fprintf(stderr, "kernel_launch: note: occupancy query reports %d workgroups per CU\n", per_cu);
        (void)hipGetLastError();
        grid = cus;
    }
    if (grid < 0) return;
    if (hipMemsetAsync((char*)d_ws + WS_CTL, 0, CTL_ZERO_BYTES, stream) != hipSuccess) { fprintf(stderr, "kernel_launch: hipMemsetAsync failed\n"); return; }
    Args a{};
    for (int i = 0; i < 7; ++i) a.in[i] = (const float*)d_in[i];
    a.out = (float*)d_out; a.ws = (unsigned char*)d_ws;
    for (int li = 0; li < N_LAUNCHES; ++li) {
        a.ph_lo = (N_LAUNCHES == 1) ? 0 : li; a.ph_hi = (N_LAUNCHES == 1) ? N_PHASES : li + 1; a.li = li;
        hipLaunchKernelGGL(hsd_fwd, dim3(grid), dim3(NWAVES * 64), LDS_BYTES, stream, a);
        const hipError_t le = hipPeekAtLastError();
        if (le != hipSuccess) { fprintf(stderr, "kernel_launch: launch %d failed: %s\n", li, hipGetErrorName(le)); break; }
    }
}
```

```cpp
#define PROBE_MODE 0
#include <hip/hip_runtime.h>
#include <hip/hip_bf16.h>
#include <cstdio>
#include <cstdint>
namespace pg8 {
#define PG8_LAS __attribute__((address_space(3)))
typedef unsigned short bf16_t;
typedef short bf16x8 __attribute__((ext_vector_type(8)));
typedef float f32x4 __attribute__((ext_vector_type(4)));
typedef unsigned u32x4 __attribute__((ext_vector_type(4)));
constexpr int BM = 256, BK = 64, HALF = 128, HTB = HALF * BK * 2  , STAGE_BYTES = 8 * HTB, NXCD = 8, WGM = 8;

__host__ __device__ __forceinline__ int lds_byte(int r, int c) { const int st = (r >> 4) * 2 + (c >> 5), rr = r & 15, cc = c & 31, ob = rr * 64 + cc * 2; return st * 1024 + (ob ^ (((ob >> 9) & 1) << 5)); }
__host__ __device__ __forceinline__ void stage_rc(int b, int& R, int& C) { const int st = b / 1024, sb = b % 1024, swz = sb ^ (((sb >> 9) & 1) << 5); R = (st >> 1) * 16 + swz / 64; C = (st & 1) * 32 + (swz % 64) / 2; }
__host__ __device__ __forceinline__ int perm32(int rho) { const int n = rho >> 4, i = rho & 15; return 8 * (i >> 2) + 4 * n + (i & 3); }

struct Unit { int pm, pn; };
struct Gemm { const bf16_t* A; const bf16_t* Bt; int M, N, K; };

struct StaticOrder {
    int nM, nN, nwg, G, c;
    __host__ __device__ void init(int M, int N, int G_, int c_) { nM = M / BM; nN = N / BM; nwg = nM * nN; G = G_; c = c_; }
    __host__ __device__ bool next(int i, Unit& u) const {
        const long L = (long)i * G + c; if (L >= nwg) return false;
        int wgid = (int)L; { const int q = nwg / NXCD, r = nwg % NXCD, xcd = wgid % NXCD, off = wgid / NXCD; wgid = (xcd < r ? xcd * (q + 1) : r * (q + 1) + (xcd - r) * q) + off; }
        const int nig = WGM * nN, gid = wgid / nig, fm = gid * WGM, gsz = (nM - fm) < WGM ? (nM - fm) : WGM;
        u.pm = fm + ((wgid % nig) % gsz); u.pn = (wgid % nig) / gsz; return true;
    }
    __device__ __forceinline__ void a_ready(const Unit&) const {}
    __device__ __forceinline__ void done(const Unit&) const {}
};

typedef float cvt_f32x2_t __attribute__((ext_vector_type(2))); typedef __bf16 cvt_bf16x2_t __attribute__((ext_vector_type(2)));
__device__ __forceinline__ unsigned cvt_pk_bf16(float lo, float hi) { cvt_f32x2_t v = {lo, hi}; cvt_bf16x2_t b = __builtin_convertvector(v, cvt_bf16x2_t); return __builtin_bit_cast(unsigned, b); }
typedef float f32x2 __attribute__((ext_vector_type(2)));
constexpr int EM = 16384;
#ifndef PROBE_MODE
#define PROBE_MODE 0
#endif
__device__ __forceinline__ float bf_lo(unsigned w) { return __uint_as_float(w << 16); }
__device__ __forceinline__ float bf_hi(unsigned w) { return __uint_as_float(w & 0xffff0000u); }
__device__ __forceinline__ float sigmoid_f(float v) { return __builtin_amdgcn_rcpf(1.0f + __builtin_amdgcn_exp2f(-1.4426950408889634f * v)); }
__device__ __forceinline__ float silu_f(float v) { return v * sigmoid_f(v); }
template <int ACT> __device__ __forceinline__ f32x4 act4(f32x4 v) {
    if (ACT == 1) { v[0] = silu_f(v[0]); v[1] = silu_f(v[1]); v[2] = silu_f(v[2]); v[3] = silu_f(v[3]); }
    if (ACT == 2) { v[0] = sigmoid_f(v[0]); v[1] = sigmoid_f(v[1]); v[2] = sigmoid_f(v[2]); v[3] = sigmoid_f(v[3]); }
    return v;
}
struct EpiProj {
    static constexpr bool PERM = true, AFTER_DRAIN = false;
    bf16_t* P9; bf16_t* G; bf16_t* kidx; float* widx;
    template <int ACT> __device__ __forceinline__ void tile(const f32x4 (&acc)[2][2][4][2], bf16_t* base, int ldc, int row0, int col0) const {
#pragma unroll
        for (int ai = 0; ai < 2; ++ai)
#pragma unroll
            for (int m = 0; m < 4; ++m) { bf16_t* rowp = base + (size_t)(row0 + ai * HALF + m * 16) * ldc + col0;
#pragma unroll
                for (int bj = 0; bj < 2; ++bj) { const f32x4 v0 = act4<ACT>(acc[ai][bj][m][0]), v1 = act4<ACT>(acc[ai][bj][m][1]);
                    u32x4 w; w.x = cvt_pk_bf16(v0[0], v0[1]); w.y = cvt_pk_bf16(v0[2], v0[3]); w.z = cvt_pk_bf16(v1[0], v1[1]); w.w = cvt_pk_bf16(v1[2], v1[3]);
                    *(u32x4*)(rowp + bj * HALF) = w; } }
    }
    __device__ __forceinline__ void operator()(const f32x4 (&acc)[2][2][4][2], const Unit& u, int wr, int wc, int fr, int fq) const {
        const int pn = u.pn, row0 = u.pm * BM + wr * 64 + fr;
        if (pn < 36) { const int t = pn >> 2; bf16_t* base = P9 + (size_t)t * ((size_t)EM * 1024); const int col0 = (pn & 3) * 256 + wc * 32 + 8 * fq;
            if (t == 3 || t == 7) tile<1>(acc, base, 1024, row0, col0); else tile<0>(acc, base, 1024, row0, col0); }
        else if (pn < 52) { tile<2>(acc, G, 4096, row0, (pn - 36) * 256 + wc * 32 + 8 * fq); }
        else {
            if (wc < 2) {
#pragma unroll
                for (int ai = 0; ai < 2; ++ai)
#pragma unroll
                    for (int m = 0; m < 4; ++m) { const f32x4 v0 = acc[ai][0][m][0], v1 = acc[ai][0][m][1];
                        u32x4 w; w.x = cvt_pk_bf16(v0[0], v0[1]); w.y = cvt_pk_bf16(v0[2], v0[3]); w.z = cvt_pk_bf16(v1[0], v1[1]); w.w = cvt_pk_bf16(v1[2], v1[3]);
                        *(u32x4*)(kidx + (size_t)(row0 + ai * HALF + m * 16) * 64 + wc * 32 + 8 * fq) = w; }
            } else if (wc == 2 && fq < 2) {
#pragma unroll
                for (int ai = 0; ai < 2; ++ai)
#pragma unroll
                    for (int m = 0; m < 4; ++m) { float* p = widx + (size_t)(row0 + ai * HALF + m * 16) * 16 + 8 * fq;
                        *(f32x4*)p = acc[ai][0][m][0]; *(f32x4*)(p + 4) = acc[ai][0][m][1]; }
            }
        }
    }
};
template <int MODE> struct EpiGate {
    static constexpr bool PERM = true, AFTER_DRAIN = false;
    const bf16_t* G; int gcol0; const bf16_t* Tin; bf16_t* Tout;
    __device__ __forceinline__ void operator()(const f32x4 (&acc)[2][2][4][2], const Unit& u, int wr, int wc, int fr, int fq) const {
        const int row0 = u.pm * BM + wr * 64 + fr, col0 = u.pn * BM + wc * 32 + 8 * fq;
#pragma unroll
        for (int ai = 0; ai < 2; ++ai)
#pragma unroll
            for (int m = 0; m < 4; ++m) { const size_t row = (size_t)(row0 + ai * HALF + m * 16);
#pragma unroll
                for (int bj = 0; bj < 2; ++bj) {
                    const u32x4 g = *(const u32x4*)(G + row * 4096 + (PROBE_MODE == 17 ? 2048 - gcol0 : gcol0) + col0 + bj * HALF);
                    f32x4 v0 = acc[ai][bj][m][0], v1 = acc[ai][bj][m][1];
                    if ((PROBE_MODE == 3 && MODE == 0) || (PROBE_MODE == 2 && MODE == 1)) { v0 = v0 * 0.f; v1 = v1 * 0.f; }
                    if (PROBE_MODE == 8 && MODE == 1) { v0 = v0 * 0.5f; v1 = v1 * 0.5f; }
                    if (PROBE_MODE == 10 || (PROBE_MODE == 14 && MODE == 1) || (PROBE_MODE == 15 && MODE == 0)) { v0 = v0 * 0.5f; v1 = v1 * 0.5f; } else {
                    float gg[8] = {bf_lo(g.x), bf_hi(g.x), bf_lo(g.y), bf_hi(g.y), bf_lo(g.z), bf_hi(g.z), bf_lo(g.w), bf_hi(g.w)};
                    if (PROBE_MODE == 20) { for (int e_ = 0; e_ < 8; ++e_) if (!(gg[e_] > 0.02f && gg[e_] < 0.98f)) gg[e_] = 0.5f; }
                    if (PROBE_MODE == 21) { for (int e_ = 0; e_ < 8; ++e_) if (!(gg[e_] >= 0.0f && gg[e_] <= 1.0f)) gg[e_] = 0.5f; }
                    if (PROBE_MODE == 25 && (gcol0 + col0 + bj * HALF) >= 3840) { for (int e_ = 0; e_ < 8; ++e_) if (!(gg[e_] >= 0.0f && gg[e_] <= 1.0f)) gg[e_] = 0.5f; }
                    if (PROBE_MODE == 26 && (gcol0 + col0 + bj * HALF) < 2048) { for (int e_ = 0; e_ < 8; ++e_) if (!(gg[e_] >= 0.0f && gg[e_] <= 1.0f)) gg[e_] = 0.5f; }
                    if (PROBE_MODE == 27 && row < 8192) { for (int e_ = 0; e_ < 8; ++e_) if (!(gg[e_] >= 0.0f && gg[e_] <= 1.0f)) gg[e_] = 0.5f; }
                    if (PROBE_MODE == 28 && (row & 255) < 128) { for (int e_ = 0; e_ < 8; ++e_) if (!(gg[e_] >= 0.0f && gg[e_] <= 1.0f)) gg[e_] = 0.5f; }
                    if (PROBE_MODE == 22) { for (int e_ = 0; e_ < 8; ++e_) if (!(gg[e_] > 1e-4f)) gg[e_] = 0.5f; }
                    v0[0] *= gg[0]; v0[1] *= gg[1]; v0[2] *= gg[2]; v0[3] *= gg[3];
                    v1[0] *= gg[4]; v1[1] *= gg[5]; v1[2] *= gg[6]; v1[3] *= gg[7]; }
                    if (MODE == 1) { const u32x4 t = *(const u32x4*)(Tin + row * 2048 + col0 + bj * HALF);
                        v0[0] += bf_lo(t.x); v0[1] += bf_hi(t.x); v0[2] += bf_lo(t.y); v0[3] += bf_hi(t.y);
                        v1[0] += bf_lo(t.z); v1[1] += bf_hi(t.z); v1[2] += bf_lo(t.w); v1[3] += bf_hi(t.w); }
                    u32x4 w; w.x = cvt_pk_bf16(v0[0], v0[1]); w.y = cvt_pk_bf16(v0[2], v0[3]); w.z = cvt_pk_bf16(v1[0], v1[1]); w.w = cvt_pk_bf16(v1[2], v1[3]);
                    *(u32x4*)(Tout + row * 2048 + col0 + bj * HALF) = w; }
                asm volatile("" ::: "memory"); }
    }
};
struct EpiOut {
    static constexpr bool PERM = false, AFTER_DRAIN = false;
    const float* x; float* h; float* pss;
    __device__ __forceinline__ void operator()(const f32x4 (&acc)[2][2][4][2], const Unit& u, int wr, int wc, int fr, int fq) const {
        const int row0 = u.pm * BM + wr * 64 + fr, col0 = u.pn * BM + wc * 32 + 4 * fq;
#pragma unroll
        for (int ai = 0; ai < 2; ++ai)
#pragma unroll
            for (int m = 0; m < 4; ++m) { const size_t row = (size_t)(row0 + ai * HALF + m * 16); float ss = 0.f;
#pragma unroll
                for (int bj = 0; bj < 2; ++bj)
#pragma unroll
                    for (int n = 0; n < 2; ++n) { const size_t off = row * 2048 + col0 + bj * HALF + n * 16;
                        const f32x4 hv = *(const f32x4*)(x + off) + (PROBE_MODE == 1 ? acc[ai][bj][m][n] * 0.f : acc[ai][bj][m][n]); *(f32x4*)(h + off) = hv;
                        ss += (hv[0] * hv[0] + hv[1] * hv[1]) + (hv[2] * hv[2] + hv[3] * hv[3]); }
                ss += __shfl_xor(ss, 16); ss += __shfl_xor(ss, 32);
                if (fq == 0) pss[row * 32 + u.pn * 4 + wc] = ss;
                asm volatile("" ::: "memory"); }
    }
};

template <class Epi, class Sched, bool ALIGN_EPI = false, bool SP2 = false>
__device__ __forceinline__ void gemm_phase(PG8_LAS unsigned char* lds, const Gemm g, const Sched& S, const Epi& E) {
    const int tid = threadIdx.x, wid = __builtin_amdgcn_readfirstlane(tid >> 6), lane = tid & 63, wr = wid >> 2, wc = wid & 3, fr = lane & 15, fq = lane >> 4;
    const int K = g.K, nt = K / BK;
    unsigned voffA[2], voffB[2];
#pragma unroll
    for (int i = 0; i < 2; ++i) { int R, C; stage_rc(tid * 16 + i * 8192, R, C); const int Rb = Epi::PERM ? ((R & ~31) + perm32(R & 31)) : R;
        voffA[i] = (unsigned)(R * K + C) * 2u; voffB[i] = (unsigned)(Rb * K + C) * 2u; }
    const size_t kstep = (size_t)(BK * 2);
    const size_t hstep = (size_t)HALF * K * 2;
    const size_t tstep = 2 * hstep;
    const unsigned ldsw = (unsigned)wid * 1024u;
    const int aoff = lds_byte(wr * 64 + fr, fq * 8), boff = lds_byte(wc * 32 + fr, fq * 8);
#define PG8_SA(b, h) (((b) * 2 + (h)) * HTB)
#define PG8_SB(b, h) ((4 + (b) * 2 + (h)) * HTB)
#define PG8_STAGE(bufoff, gbase, voff) do { _Pragma("unroll") for (int _i = 0; _i < 2; ++_i) \
        __builtin_amdgcn_global_load_lds((const unsigned*)((const char*)(gbase) + (voff)[_i]), (PG8_LAS unsigned*)(lds + (bufoff) + ldsw + _i * 8192), 16, 0, 0); } while (0)
#define PG8_LDA(dst, b, h) do { _Pragma("unroll") for (int m = 0; m < 4; ++m) _Pragma("unroll") for (int k = 0; k < 2; ++k) dst[m][k] = *(const PG8_LAS bf16x8*)(lds + PG8_SA(b, h) + aoff + m * 2048 + k * 1024); } while (0)
#define PG8_LDB(dst, b, h) do { _Pragma("unroll") for (int n = 0; n < 2; ++n) _Pragma("unroll") for (int k = 0; k < 2; ++k) dst[n][k] = *(const PG8_LAS bf16x8*)(lds + PG8_SB(b, h) + boff + n * 2048 + k * 1024); } while (0)
#define PG8_MMA(ai, bj, At, Bt) do { __builtin_amdgcn_s_setprio(1); _Pragma("unroll") for (int m = 0; m < 4; ++m) _Pragma("unroll") for (int n = 0; n < 2; ++n) _Pragma("unroll") for (int k = 0; k < 2; ++k) \
        acc[ai][bj][m][n] = __builtin_amdgcn_mfma_f32_16x16x32_bf16(Bt[n][k], At[m][k], acc[ai][bj][m][n], 0, 0, 0); __builtin_amdgcn_s_setprio(0); } while (0)
#define PG8_WAIT_V(n) asm volatile("s_waitcnt vmcnt(" #n ")" ::: "memory")
#define PG8_WAIT_L(n) asm volatile("s_waitcnt lgkmcnt(" #n ")" ::: "memory")
#define PG8_BAR __builtin_amdgcn_s_barrier()
#define PG8_SCHED __builtin_amdgcn_sched_barrier(0)
    Unit cur, nxt; int ui = 0;
    if (!S.next(0, cur)) return;
    f32x4 acc[2][2][4][2];
#pragma unroll
    for (int a = 0; a < 2; ++a)
#pragma unroll
        for (int b = 0; b < 2; ++b)
#pragma unroll
            for (int m = 0; m < 4; ++m)
#pragma unroll
                for (int n = 0; n < 2; ++n) acc[a][b][m][n] = (f32x4){0.f, 0.f, 0.f, 0.f};
    bf16x8 At[4][2], B0[2][2], B1[2][2];
    const char* cA = (const char*)g.A + (size_t)cur.pm * tstep; const char* cB = (const char*)g.Bt + (size_t)cur.pn * tstep;
    S.a_ready(cur);
    if constexpr (SP2) {
        PG8_STAGE(PG8_SB(0, 0), cB, voffB); PG8_STAGE(PG8_SB(0, 1), cB + hstep, voffB); PG8_STAGE(PG8_SA(0, 0), cA, voffA); PG8_STAGE(PG8_SA(0, 1), cA + hstep, voffA);
        if (wr == 1) PG8_BAR;
        PG8_WAIT_V(2); PG8_BAR;
        PG8_STAGE(PG8_SB(1, 0), cB + kstep, voffB); PG8_STAGE(PG8_SA(1, 0), cA + kstep, voffA); PG8_STAGE(PG8_SB(1, 1), cB + hstep + kstep, voffB);
        PG8_WAIT_V(6); PG8_BAR;
    } else {
        PG8_STAGE(PG8_SB(0, 0), cB, voffB); PG8_STAGE(PG8_SA(0, 0), cA, voffA); PG8_STAGE(PG8_SB(0, 1), cB + hstep, voffB); PG8_STAGE(PG8_SA(0, 1), cA + hstep, voffA);
        if (wr == 1) PG8_BAR;
        PG8_WAIT_V(4); PG8_BAR;
        PG8_STAGE(PG8_SB(1, 0), cB + kstep, voffB); PG8_STAGE(PG8_SA(1, 0), cA + kstep, voffA); PG8_STAGE(PG8_SB(1, 1), cB + hstep + kstep, voffB);
        PG8_WAIT_V(6); PG8_BAR;
    }
    for (;;) {
        const bool has_next = S.next(ui + 1, nxt);
        const char* nA = has_next ? (const char*)g.A + (size_t)nxt.pm * tstep : cA; const char* nB = has_next ? (const char*)g.Bt + (size_t)nxt.pn * tstep : cB;
        for (int t = 0; t < nt; t += 2) {
            const bool last = (t == nt - 2);
            const char* a1 = cA + (size_t)(t + 1) * kstep;
            const char* a2 = last ? nA : cA + (size_t)(t + 2) * kstep; const char* b2 = last ? nB : cB + (size_t)(t + 2) * kstep;
            const char* a3 = a2 + kstep; const char* b3 = b2 + kstep;
            if (last && has_next) S.a_ready(nxt);
            if constexpr (SP2) {
            PG8_LDB(B0, 0, 0); PG8_LDB(B1, 0, 1); PG8_SCHED; PG8_LDA(At, 0, 0); PG8_STAGE(PG8_SA(1, 1), a1 + hstep, voffA);
            PG8_WAIT_V(8); PG8_WAIT_L(0); PG8_BAR; PG8_MMA(0, 0, At, B0); PG8_MMA(0, 1, At, B1); PG8_BAR; PG8_SCHED;
            PG8_LDA(At, 0, 1); PG8_STAGE(PG8_SB(0, 0), b2, voffB); PG8_STAGE(PG8_SB(0, 1), b2 + hstep, voffB); PG8_STAGE(PG8_SA(0, 0), a2, voffA);
            PG8_WAIT_V(8); PG8_WAIT_L(0); PG8_BAR; PG8_MMA(1, 0, At, B0); PG8_MMA(1, 1, At, B1); PG8_BAR; PG8_SCHED;
            PG8_LDB(B0, 1, 0); PG8_LDB(B1, 1, 1); PG8_SCHED; PG8_LDA(At, 1, 0); PG8_STAGE(PG8_SA(0, 1), a2 + hstep, voffA);
            PG8_WAIT_V(8); PG8_WAIT_L(0); PG8_BAR; PG8_MMA(0, 0, At, B0); PG8_MMA(0, 1, At, B1); PG8_BAR; PG8_SCHED;
            PG8_LDA(At, 1, 1); PG8_STAGE(PG8_SB(1, 0), b3, voffB); PG8_STAGE(PG8_SB(1, 1), b3 + hstep, voffB); PG8_STAGE(PG8_SA(1, 0), a3, voffA);
            PG8_WAIT_V(8); PG8_WAIT_L(0); PG8_BAR; PG8_MMA(1, 0, At, B0); PG8_MMA(1, 1, At, B1); PG8_BAR; PG8_SCHED;
            } else {
            PG8_LDB(B0, 0, 0); PG8_SCHED; PG8_LDA(At, 0, 0); PG8_STAGE(PG8_SA(1, 1), a1 + hstep, voffA);
            PG8_WAIT_L(8); PG8_BAR; PG8_WAIT_L(0); PG8_MMA(0, 0, At, B0); PG8_BAR; PG8_SCHED;
            PG8_LDB(B1, 0, 1); PG8_STAGE(PG8_SB(0, 0), b2, voffB);
            PG8_BAR; PG8_WAIT_L(0); PG8_MMA(0, 1, At, B1); PG8_BAR;
            PG8_LDA(At, 0, 1); PG8_STAGE(PG8_SA(0, 0), a2, voffA);
            PG8_BAR; PG8_WAIT_L(0); PG8_MMA(1, 0, At, B0); PG8_BAR; PG8_SCHED;
            PG8_STAGE(PG8_SB(0, 1), b2 + hstep, voffB);
            PG8_WAIT_V(6); PG8_BAR; PG8_MMA(1, 1, At, B1); PG8_BAR;
            PG8_LDB(B0, 1, 0); PG8_SCHED; PG8_LDA(At, 1, 0); PG8_STAGE(PG8_SA(0, 1), a2 + hstep, voffA);
            PG8_WAIT_L(8); PG8_BAR; PG8_WAIT_L(0); PG8_MMA(0, 0, At, B0); PG8_BAR; PG8_SCHED;
            PG8_LDB(B1, 1, 1); PG8_STAGE(PG8_SB(1, 0), b3, voffB);
            PG8_BAR; PG8_WAIT_L(0); PG8_MMA(0, 1, At, B1); PG8_BAR;
            PG8_LDA(At, 1, 1); PG8_STAGE(PG8_SA(1, 0), a3, voffA);
            PG8_BAR; PG8_WAIT_L(0); PG8_MMA(1, 0, At, B0); PG8_BAR; PG8_SCHED;
            PG8_STAGE(PG8_SB(1, 1), b3 + hstep, voffB);
            PG8_WAIT_V(6); PG8_BAR; PG8_MMA(1, 1, At, B1); PG8_BAR;
            }
        }
        if constexpr (ALIGN_EPI) { if (wr == 0) PG8_BAR; }
        if constexpr (!Epi::AFTER_DRAIN) { E(acc, cur, wr, wc, fr, fq); S.done(cur); }
        if (!has_next) break;
#pragma unroll
        for (int a = 0; a < 2; ++a)
#pragma unroll
            for (int b = 0; b < 2; ++b)
#pragma unroll
                for (int m = 0; m < 4; ++m)
#pragma unroll
                    for (int n = 0; n < 2; ++n) acc[a][b][m][n] = (f32x4){0.f, 0.f, 0.f, 0.f};
        cur = nxt; cA = nA; cB = nB; ++ui;
        if constexpr (ALIGN_EPI) { if (wr == 1) PG8_BAR; }
    }
    PG8_WAIT_V(0);
    if constexpr (!ALIGN_EPI) { if (wr == 0) PG8_BAR; }
    PG8_BAR;
    if constexpr (Epi::AFTER_DRAIN) { E.fused(acc, cur, wr, wc, fr, fq, lds, wid, lane); S.done(cur); }
#undef PG8_SA
#undef PG8_SB
#undef PG8_STAGE
#undef PG8_LDA
#undef PG8_LDB
#undef PG8_MMA
#undef PG8_WAIT_V
#undef PG8_WAIT_L
#undef PG8_BAR
#undef PG8_SCHED
}
}
namespace att {
typedef unsigned short bf16;
using bf16x8 = __attribute__((ext_vector_type(8))) short;
using s16x4  = __attribute__((ext_vector_type(4))) short;
using f32x16 = __attribute__((ext_vector_type(16))) float;
using u32x4  = __attribute__((ext_vector_type(4))) unsigned;
using u32x2  = __attribute__((ext_vector_type(2))) unsigned;
constexpr int D = 128, NW = 8, QBLK = 32, KVBLK = 64, SEQ = 8192, LDK = 1024;
constexpr size_t SHM_V = KVBLK * D * 2, SHM_K = KVBLK * D * 2, SHM_ATTN = 2 * SHM_V + 2 * SHM_K + NW * 64 * 4;
#define KSWZ(row, colB) ((row) * 256 + ((colB) ^ (((row) & 7) << 4)))
#define SBAR() __builtin_amdgcn_sched_barrier(0)
__device__ __forceinline__ int crow(int r, int hi) { return (r & 3) + 8 * (r >> 2) + 4 * hi; }
__device__ __forceinline__ constexpr int crow0(int r) { return (r & 3) + 8 * (r >> 2); }
typedef float cvt_f32x2_t __attribute__((ext_vector_type(2))); typedef __bf16 cvt_bf16x2_t __attribute__((ext_vector_type(2)));
__device__ __forceinline__ unsigned cvtpk(float lo, float hi) { cvt_f32x2_t v = {lo, hi}; cvt_bf16x2_t b = __builtin_convertvector(v, cvt_bf16x2_t); return __builtin_bit_cast(unsigned, b); }
__device__ __forceinline__ float bf2f(bf16 x) { return __uint_as_float((unsigned)x << 16); }
__device__ __forceinline__ bf16x8 ld8(const bf16* p) { return *reinterpret_cast<const bf16x8*>(p); }
#define ATT_PK4(P, BASE, OUT) do { unsigned a0 = cvtpk(P[BASE + 0], P[BASE + 1]), a1 = cvtpk(P[BASE + 2], P[BASE + 3]);   \
    unsigned b0 = cvtpk(P[BASE + 4], P[BASE + 5]), b1 = cvtpk(P[BASE + 6], P[BASE + 7]);                              \
    auto r0 = __builtin_amdgcn_permlane32_swap(a0, b0, false, false); auto r1 = __builtin_amdgcn_permlane32_swap(a1, b1, false, false); \
    u32x4 w = {r0[0], r1[0], r0[1], r1[1]}; OUT = *reinterpret_cast<bf16x8*>(&w); } while (0)
__device__ __forceinline__ void pack_p(const f32x16& p0, const f32x16& p1, bf16x8& pa0, bf16x8& pa1, bf16x8& pa2, bf16x8& pa3) {
  ATT_PK4(p0, 0, pa0); ATT_PK4(p0, 8, pa1); ATT_PK4(p1, 0, pa2); ATT_PK4(p1, 8, pa3);
}
__device__ __forceinline__ void qkt(f32x16& p0, f32x16& p1, const bf16* Ks, const bf16x8* qr, int r32, int hi) {
  p0 = f32x16{}; p1 = f32x16{};
#pragma unroll
  for (int d0 = 0; d0 < 8; ++d0) { int cb = (d0 * 16 + hi * 8) * 2;
    bf16x8 b0 = *reinterpret_cast<const bf16x8*>((const char*)Ks + KSWZ(r32, cb));
    bf16x8 b1 = *reinterpret_cast<const bf16x8*>((const char*)Ks + KSWZ(32 + r32, cb));
    p0 = __builtin_amdgcn_mfma_f32_32x32x16_bf16(b0, qr[d0], p0, 0, 0, 0);
    p1 = __builtin_amdgcn_mfma_f32_32x32x16_bf16(b1, qr[d0], p1, 0, 0, 0); }
}
__device__ __forceinline__ int v_st(int k, int c) { const int kk = (k & ~0xC) | ((k & 4) << 1) | ((k & 8) >> 1); return ((kk >> 3) * 4 + (c >> 5)) * 512 + ((kk & 7) * 32 + (c & 31)) * 2; }
__device__ __forceinline__ int v_rd_base(int lane) { return ((lane & 3) << 3) | (((lane >> 2) & 3) << 6) | (((lane >> 4) & 1) << 5) | (((lane >> 5) & 1) << 8); }
constexpr int v_rd_off(int d0, int ks, int half) { return d0 * 512 + ks * 4096 + half * 2048; }
template <int OFF> __device__ __forceinline__ s16x4 tr_read(int vb) {
  s16x4 r; asm volatile("ds_read_b64_tr_b16 %0, %1 offset:%2" : "=&v"(r) : "v"(vb), "i"(OFF) : "memory"); return r;
}
template <int D0> __device__ __forceinline__ void pv_one(f32x16& od, int vb, bf16x8 pa0, bf16x8 pa1, bf16x8 pa2, bf16x8 pa3) {
  const s16x4 l0 = tr_read<v_rd_off(D0, 0, 0)>(vb), h0 = tr_read<v_rd_off(D0, 0, 1)>(vb), l1 = tr_read<v_rd_off(D0, 1, 0)>(vb), h1 = tr_read<v_rd_off(D0, 1, 1)>(vb);
  const s16x4 l2 = tr_read<v_rd_off(D0, 2, 0)>(vb), h2 = tr_read<v_rd_off(D0, 2, 1)>(vb), l3 = tr_read<v_rd_off(D0, 3, 0)>(vb), h3 = tr_read<v_rd_off(D0, 3, 1)>(vb);
  asm volatile("s_waitcnt lgkmcnt(0)" ::: "memory"); SBAR();
#define ATT_PK(L, H) (bf16x8){L[0], L[1], L[2], L[3], H[0], H[1], H[2], H[3]}
  od = __builtin_amdgcn_mfma_f32_32x32x16_bf16(pa0, ATT_PK(l0, h0), od, 0, 0, 0);
  od = __builtin_amdgcn_mfma_f32_32x32x16_bf16(pa1, ATT_PK(l1, h1), od, 0, 0, 0);
  od = __builtin_amdgcn_mfma_f32_32x32x16_bf16(pa2, ATT_PK(l2, h2), od, 0, 0, 0);
  od = __builtin_amdgcn_mfma_f32_32x32x16_bf16(pa3, ATT_PK(l3, h3), od, 0, 0, 0);
#undef ATT_PK
}
__device__ __forceinline__ void pv_d0(f32x16* o, int vb, bf16x8 pa0, bf16x8 pa1, bf16x8 pa2, bf16x8 pa3) {
  pv_one<0>(o[0], vb, pa0, pa1, pa2, pa3); pv_one<1>(o[1], vb, pa0, pa1, pa2, pa3); pv_one<2>(o[2], vb, pa0, pa1, pa2, pa3); pv_one<3>(o[3], vb, pa0, pa1, pa2, pa3);
}
__device__ __forceinline__ void store_act(const f32x16* o, const float* rli, bf16* Ow, const bf16* Zw, int r32, int hi) {
  int lbase = 4 * hi * LDK + r32; asm volatile("" : "+v"(lbase));
#pragma unroll
  for (int r = 0; r < 16; ++r) { const int off = crow0(r) * LDK + lbase;
    const float z0 = bf2f(Zw[off]), z1 = bf2f(Zw[off + 32]), z2 = bf2f(Zw[off + 64]), z3 = bf2f(Zw[off + 96]);
    const float v0 = o[0][r] * rli[r] * z0, v1 = o[1][r] * rli[r] * z1, v2 = o[2][r] * rli[r] * z2, v3 = o[3][r] * rli[r] * z3;
    Ow[off] = (bf16)(cvtpk(v0, v0) & 0xffffu); Ow[off + 32] = (bf16)(cvtpk(v1, v1) & 0xffffu); Ow[off + 64] = (bf16)(cvtpk(v2, v2) & 0xffffu); Ow[off + 96] = (bf16)(cvtpk(v3, v3) & 0xffffu);
    if (r & 1) asm volatile("" ::: "memory"); }
}

__device__ __forceinline__ void sb_unit(int b, int h, int qb, bf16* Q, const bf16* __restrict__ K, const bf16* __restrict__ V, const bf16* __restrict__ Zs, char* lds) {
  const int tid = threadIdx.x, wid = tid >> 6, lane = tid & 63, r32 = lane & 31, hi = lane >> 5;
  bf16* V_lds = (bf16*)lds; bf16* K_lds = (bf16*)(lds + SHM_V); int* flags = (int*)(lds + SHM_V + SHM_K);
  const long rowbase = (long)b * SEQ; const int t0 = qb * 256 + wid * 32, tq = t0 + r32;
  bf16x8 qr[8];
  { const bf16* Qw = Q + (rowbase + tq) * LDK + h * D + hi * 8;
#pragma unroll
    for (int d0 = 0; d0 < 8; ++d0) qr[d0] = ld8(Qw + d0 * 16); }
  const bf16* Kh = K + rowbase * LDK + h * D; const bf16* Vh = V + rowbase * LDK + h * D;
  const int sr = tid >> 4, sc = (tid & 15) * 8, vst0 = v_st(sr, sc), vst1 = v_st(32 + sr, sc);
  const int vb0 = (int)(uintptr_t)V_lds + v_rd_base(lane);
  f32x16 o[4] = {}; float carry = 0.f; bool done = false;
  const int NT = 4 * qb + 4, jw = 4 * qb + (wid >> 1);
  bf16x8 vs0, vs1, ks0, ks1;
#define SB_LOAD(k0) do { vs0 = ld8(&Vh[(long)((k0) + sr) * LDK + sc]); vs1 = ld8(&Vh[(long)((k0) + 32 + sr) * LDK + sc]); \
    ks0 = ld8(&Kh[(long)((k0) + sr) * LDK + sc]); ks1 = ld8(&Kh[(long)((k0) + 32 + sr) * LDK + sc]); } while (0)
  SB_LOAD((NT - 1) * KVBLK);
  for (int j = NT - 1; j >= 0; --j) {
    *(bf16x8*)((char*)V_lds + vst0) = vs0; *(bf16x8*)((char*)V_lds + vst1) = vs1;
    *(bf16x8*)((char*)K_lds + KSWZ(sr, sc * 2)) = ks0; *(bf16x8*)((char*)K_lds + KSWZ(32 + sr, sc * 2)) = ks1;
    __syncthreads();
    if (j > 0) SB_LOAD((j - 1) * KVBLK);
    if (j <= jw && !done) {
      f32x16 p0, p1; qkt(p0, p1, K_lds, qr, r32, hi);
      const bool diag = (j == jw); const int srel = tq - 64 * j - 4 * hi;
      const float fsel = hi ? 0.f : 1.f; float run = 0.f;
      { float L1[16];
#pragma unroll
        for (int r = 0; r < 16; ++r) { const float z = p1[r]; const float e = __builtin_amdgcn_exp2f(-__builtin_fabsf(z)); float L = -(__builtin_fmaxf(z, 0.f) + __builtin_amdgcn_logf(1.0f + e));
          if (diag && !(crow0(r) + 32 < srel)) L = 0.f; L1[r] = L; }
        float bb[4], pb[4], base1[4];
#pragma unroll
        for (int g = 0; g < 4; ++g) bb[g] = (L1[4 * g] + L1[4 * g + 1]) + (L1[4 * g + 2] + L1[4 * g + 3]);
#pragma unroll
        for (int g = 0; g < 4; ++g) pb[g] = __shfl_xor(bb[g], 32);
#pragma unroll
        for (int g = 3; g >= 0; --g) { base1[g] = run + fsel * pb[g]; run += bb[g] + pb[g]; }
#pragma unroll
        for (int g = 0; g < 4; ++g) { float s1 = carry + base1[g];
#pragma unroll
          for (int i = 3; i >= 0; --i) { const int r = 4 * g + i; s1 += L1[r]; float w1 = __builtin_amdgcn_exp2f(p1[r] + s1); if (diag && !(crow0(r) + 32 < srel)) w1 = 0.f; p1[r] = w1; } }
      }
      SBAR();
      { float L0[16];
#pragma unroll
        for (int r = 0; r < 16; ++r) { const float z = p0[r]; const float e = __builtin_amdgcn_exp2f(-__builtin_fabsf(z)); float L = -(__builtin_fmaxf(z, 0.f) + __builtin_amdgcn_logf(1.0f + e));
          if (diag && !(crow0(r) < srel)) L = 0.f; L0[r] = L; }
        float a[4], pa[4], base0[4];
#pragma unroll
        for (int g = 0; g < 4; ++g) a[g] = (L0[4 * g] + L0[4 * g + 1]) + (L0[4 * g + 2] + L0[4 * g + 3]);
#pragma unroll
        for (int g = 0; g < 4; ++g) pa[g] = __shfl_xor(a[g], 32);
#pragma unroll
        for (int g = 3; g >= 0; --g) { base0[g] = run + fsel * pa[g]; run += a[g] + pa[g]; }
#pragma unroll
        for (int g = 0; g < 4; ++g) { float s0 = carry + base0[g];
#pragma unroll
          for (int i = 3; i >= 0; --i) { const int r = 4 * g + i; s0 += L0[r]; float w0 = __builtin_amdgcn_exp2f(p0[r] + s0); if (diag && !(crow0(r) < srel)) w0 = 0.f; p0[r] = w0; } }
      }
      carry += run;
      bf16x8 pa0, pa1, pa2, pa3; pack_p(p0, p1, pa0, pa1, pa2, pa3);
      SBAR(); pv_d0(o, vb0, pa0, pa1, pa2, pa3);
      done = __all(carry < -160.f);
    }
    if (lane == 0) flags[wid] = done ? 1 : 0;
    __syncthreads();
    const int alld = flags[0] & flags[1] & flags[2] & flags[3] & flags[4] & flags[5] & flags[6] & flags[7];
    if (alld) break;
  }
#undef SB_LOAD
  float rli[16];
#pragma unroll
  for (int r = 0; r < 16; ++r) rli[r] = 1.0f;
  store_act(o, rli, Q + (rowbase + t0) * LDK + h * D, Zs + (rowbase + t0) * LDK + h * D, r32, hi);
  __syncthreads();
}

constexpr float THR2 = 11.5f;
__device__ __forceinline__ void sa_partial(f32x16& p0, f32x16& p1, float& m_reg, float& mn, float& alpha, u32x2 mw, float dbase, float nslope2, int hi) {
  const unsigned mx = mw.x >> (4 * hi), my = mw.y >> (4 * hi);
#pragma unroll
  for (int r = 0; r < 16; ++r) {
    const float d0 = dbase - (float)crow0(r), d1 = dbase - (float)(crow0(r) + 32);
    float x0 = __builtin_fmaf(__builtin_fabsf(d0), nslope2, p0[r]), x1 = __builtin_fmaf(__builtin_fabsf(d1), nslope2, p1[r]);
    const int s0 = ((int)(mx << (31 - crow0(r)))) >> 31, s1 = ((int)(my << (31 - crow0(r)))) >> 31;
    p0[r] = __int_as_float((__float_as_int(x0) & s0) | (~s0 & (int)0xff800000));
    p1[r] = __int_as_float((__float_as_int(x1) & s1) | (~s1 & (int)0xff800000));
  }
  float pmax = p0[0];
#pragma unroll
  for (int r = 1; r < 16; ++r) pmax = fmaxf(pmax, p0[r]);
#pragma unroll
  for (int r = 0; r < 16; ++r) pmax = fmaxf(pmax, p1[r]);
  { auto rr = __builtin_amdgcn_permlane32_swap(__float_as_uint(pmax), __float_as_uint(pmax), false, false);
    pmax = fmaxf(__uint_as_float(rr[0]), __uint_as_float(rr[1])); }
  if (__builtin_expect(__all(pmax - m_reg <= THR2), 1)) { mn = m_reg; alpha = 1.f; }
  else { mn = fmaxf(m_reg, pmax); alpha = __builtin_amdgcn_exp2f(m_reg - mn); m_reg = mn; }
#pragma unroll
  for (int r = 0; r < 16; ++r) { p0[r] = p0[r] - mn; p1[r] = p1[r] - mn; }
#pragma unroll
  for (int r = 0; r < 16; ++r) p0[r] = __builtin_amdgcn_exp2f(p0[r]);
}
__device__ __forceinline__ void sa_finish(f32x16& p0, f32x16& p1, float alpha, float& l_reg, bf16x8& pa0, bf16x8& pa1, bf16x8& pa2, bf16x8& pa3) {
#pragma unroll
  for (int r = 0; r < 16; ++r) p1[r] = __builtin_amdgcn_exp2f(p1[r]);
  float ps = 0;
#pragma unroll
  for (int r = 0; r < 16; ++r) ps += p0[r];
#pragma unroll
  for (int r = 0; r < 16; ++r) ps += p1[r];
  { auto rr = __builtin_amdgcn_permlane32_swap(__float_as_uint(ps), __float_as_uint(ps), false, false);
    ps = __uint_as_float(rr[0]) + __uint_as_float(rr[1]); }
  l_reg = l_reg * alpha + ps;
  pack_p(p0, p1, pa0, pa1, pa2, pa3);
}
__device__ __forceinline__ void sa_unit(int b, int h, int qb, bf16* Q, const bf16* __restrict__ K, const bf16* __restrict__ V, const bf16* __restrict__ Zs,
                                        const u32x2* __restrict__ maskp, char* lds) {
  const int tid = threadIdx.x, wid = tid >> 6, lane = tid & 63, r32 = lane & 31, hi = lane >> 5;
  bf16* V_lds = (bf16*)lds; bf16* K_lds = (bf16*)(lds + 2 * SHM_V);
  float* ws = (float*)(lds + 2 * SHM_V + 2 * SHM_K) + wid * 64; float* li_l = ws; float* al_l = ws + 32;
  const long rowbase = (long)b * SEQ; const int t0 = qb * 256 + wid * 32, tq = t0 + r32;
  float m_reg = -1e30f, l_reg = 0; f32x16 o[4] = {}; bf16x8 qr[8];
  { const bf16* Qw = Q + (rowbase + tq) * LDK + h * D + hi * 8;
#pragma unroll
    for (int d0 = 0; d0 < 8; ++d0) qr[d0] = ld8(Qw + d0 * 16); }
  const bf16* Kh = K + rowbase * LDK + h * D; const bf16* Vh = V + rowbase * LDK + h * D;
  const u32x2* mrow = maskp + (rowbase + tq) * 128;
  const float nslope2 = -1.4426950408889634f * __builtin_amdgcn_exp2f(-(float)(h + 1));
  const int sr = tid >> 4, sc = (tid & 15) * 8, vst0 = v_st(sr, sc), vst1 = v_st(32 + sr, sc);
  const int vb0 = (int)(uintptr_t)V_lds + v_rd_base(lane);
  struct { bf16x8 vs0, vs1, ks0, ks1; } sr_[1];
  const int NT = 4 * qb + 4;
#define KOF(i) ((NT - 1 - (i)) * KVBLK)
#define DBASE(i) ((float)(tq - KOF(i) - 4 * hi))
#define SLOAD(i, k0) do { sr_[i].vs0 = ld8(&Vh[(long)((k0) + sr) * LDK + sc]); sr_[i].vs1 = ld8(&Vh[(long)((k0) + 32 + sr) * LDK + sc]); \
    sr_[i].ks0 = ld8(&Kh[(long)((k0) + sr) * LDK + sc]); sr_[i].ks1 = ld8(&Kh[(long)((k0) + 32 + sr) * LDK + sc]); } while (0)
#define SWRITE(bf, i) do { *(bf16x8*)((char*)V_lds + (bf) * SHM_V + vst0) = sr_[i].vs0;          \
    *(bf16x8*)((char*)V_lds + (bf) * SHM_V + vst1) = sr_[i].vs1; int kc = sc * 2;               \
    *(bf16x8*)((char*)K_lds + (bf) * SHM_K + KSWZ(sr, kc)) = sr_[i].ks0;                       \
    *(bf16x8*)((char*)K_lds + (bf) * SHM_K + KSWZ(32 + sr, kc)) = sr_[i].ks1; } while (0)
#define SWAIT() asm volatile("s_waitcnt vmcnt(0)" ::: "memory")
#define RESC(a) do { if (__any((a) < 1.f)) { if (hi == 0) al_l[r32] = (a); asm volatile("s_waitcnt lgkmcnt(0)" ::: "memory"); \
    _Pragma("unroll") for (int d = 0; d < 4; ++d) _Pragma("unroll") for (int r = 0; r < 16; ++r) o[d][r] *= al_l[crow(r, hi)]; } } while (0)
  f32x16 pA0, pA1, pB0, pB1; float mnA, mnB, alA, alB; bf16x8 pa0, pa1, pa2, pa3;
  constexpr int SE = 0, SO = 0;
  u32x2 mwA = mrow[NT - 1], mwB;
  SLOAD(SE, KOF(0)); asm volatile("s_waitcnt vmcnt(0)" ::: "memory"); SWRITE(0, SE); __syncthreads();
  qkt(pA0, pA1, K_lds, qr, r32, hi); sa_partial(pA0, pA1, m_reg, mnA, alA, mwA, DBASE(0), nslope2, hi);
  SLOAD(SO, KOF(1));
  SWAIT(); SWRITE(1, SO); __syncthreads();
  for (int j = 1; j + 1 < NT; j += 2) {
    mwB = mrow[NT - 1 - j];
    SBAR(); qkt(pB0, pB1, (bf16*)((char*)K_lds + SHM_K), qr, r32, hi);
    sa_finish(pA0, pA1, alA, l_reg, pa0, pa1, pa2, pa3); SBAR();
    SLOAD(SE, KOF(j + 1)); SBAR();
    pv_d0(o, vb0, pa0, pa1, pa2, pa3); sa_partial(pB0, pB1, m_reg, mnB, alB, mwB, DBASE(j), nslope2, hi);
    __syncthreads(); SWAIT(); SWRITE(0, SE);
    RESC(alB); __syncthreads();
    mwA = mrow[NT - 2 - j];
    SBAR(); qkt(pA0, pA1, K_lds, qr, r32, hi);
    sa_finish(pB0, pB1, alB, l_reg, pa0, pa1, pa2, pa3); SBAR();
    SLOAD(SO, KOF(j + 2)); SBAR();
    pv_d0(o, vb0 + (int)SHM_V, pa0, pa1, pa2, pa3); sa_partial(pA0, pA1, m_reg, mnA, alA, mwA, DBASE(j + 1), nslope2, hi);
    __syncthreads(); SWAIT(); SWRITE(1, SO);
    RESC(alA); __syncthreads();
  }
  mwB = mrow[0];
  SBAR(); qkt(pB0, pB1, (bf16*)((char*)K_lds + SHM_K), qr, r32, hi);
  sa_finish(pA0, pA1, alA, l_reg, pa0, pa1, pa2, pa3); SBAR();
  pv_d0(o, vb0, pa0, pa1, pa2, pa3); sa_partial(pB0, pB1, m_reg, mnB, alB, mwB, DBASE(NT - 1), nslope2, hi);
  __syncthreads(); RESC(alB);
  sa_finish(pB0, pB1, alB, l_reg, pa0, pa1, pa2, pa3); SBAR();
  pv_d0(o, vb0 + (int)SHM_V, pa0, pa1, pa2, pa3);
  if (hi == 0) li_l[r32] = l_reg; asm volatile("s_waitcnt lgkmcnt(0)" ::: "memory");
  float rli[16];
#pragma unroll
  for (int r = 0; r < 16; ++r) rli[r] = __builtin_amdgcn_rcpf(li_l[crow(r, hi)]);
  store_act(o, rli, Q + (rowbase + t0) * LDK + h * D, Zs + (rowbase + t0) * LDK + h * D, r32, hi);
  __syncthreads();
#undef KOF
#undef DBASE
#undef SLOAD
#undef SWRITE
#undef SWAIT
#undef RESC
}
#undef KSWZ
#undef SBAR
}

namespace idx {
typedef unsigned short bf16;
using bf16x8 = __attribute__((ext_vector_type(8))) short;
using f32x4  = __attribute__((ext_vector_type(4))) float;
using u32x4  = __attribute__((ext_vector_type(4))) unsigned;
using u32x2  = __attribute__((ext_vector_type(2))) unsigned;
constexpr int SEQ = 8192;
__device__ __forceinline__ float bf2f(short x) { return __uint_as_float(((unsigned)(unsigned short)x) << 16); }
typedef float cvt_f32x2_t __attribute__((ext_vector_type(2))); typedef __bf16 cvt_bf16x2_t __attribute__((ext_vector_type(2)));
__device__ __forceinline__ unsigned cvtpk(float lo, float hi) { cvt_f32x2_t v = {lo, hi}; cvt_bf16x2_t b = __builtin_convertvector(v, cvt_bf16x2_t); return __builtin_bit_cast(unsigned, b); }
__device__ __forceinline__ unsigned monokey(float s) { const unsigned u = __float_as_uint(s); return u ^ ((unsigned)((int)u >> 31) | 0x80000000u); }

#define IDX_SCORE(sc, ka0, ka1) do { \
    sc = __builtin_amdgcn_mfma_f32_16x16x32_bf16(ka0, qlin0, (f32x4){0.f, 0.f, 0.f, 0.f}, 0, 0, 0); sc = __builtin_amdgcn_mfma_f32_16x16x32_bf16(ka1, qlin1, sc, 0, 0, 0); \
    _Pragma("unroll") for (int h_ = 0; h_ < 16; ++h_) { \
      f32x4 x_ = __builtin_amdgcn_mfma_f32_16x16x32_bf16(ka0, q[h_][0], (f32x4){0.f, 0.f, 0.f, 0.f}, 0, 0, 0); x_ = __builtin_amdgcn_mfma_f32_16x16x32_bf16(ka1, q[h_][1], x_, 0, 0, 0); \
      sc[0] = __builtin_fmaf(__builtin_fabsf(x_[0]), wh[h_], sc[0]); sc[1] = __builtin_fmaf(__builtin_fabsf(x_[1]), wh[h_], sc[1]); \
      sc[2] = __builtin_fmaf(__builtin_fabsf(x_[2]), wh[h_], sc[2]); sc[3] = __builtin_fmaf(__builtin_fabsf(x_[3]), wh[h_], sc[3]); \
      __builtin_amdgcn_sched_barrier(0); } } while (0)

__device__ __forceinline__ void idx_unit(int b, int c, int hf, const bf16* __restrict__ Qidx, const bf16* __restrict__ kidx, const float* __restrict__ widx, u32x2* maskp, char* lds) {
  const int tid = threadIdx.x, wid = tid >> 6, lane = tid & 63, g = wid & 1, kq = wid >> 1, qi = lane & 15, kg = lane >> 4;
  const int t = 64 * c + 32 * hf + 16 * g + qi; const long rowg = (long)b * SEQ + t;
  const int NT = c + 1;
  unsigned* cntbuf = (unsigned*)lds;
  bf16x8 q[16][2]; float wh[16];
#pragma unroll
  for (int h = 0; h < 16; ++h) {
    q[h][0] = *reinterpret_cast<const bf16x8*>(Qidx + rowg * 1024 + h * 64 + kg * 8);
    q[h][1] = *reinterpret_cast<const bf16x8*>(Qidx + rowg * 1024 + h * 64 + 32 + kg * 8);
    wh[h] = 0.5f * widx[rowg * 16 + h];
  }
  bf16x8 qlin0, qlin1;
  { float l0[8], l1[8];
#pragma unroll
    for (int e = 0; e < 8; ++e) { l0[e] = 0.f; l1[e] = 0.f; }
#pragma unroll
    for (int h = 0; h < 16; ++h)
#pragma unroll
      for (int e = 0; e < 8; ++e) { l0[e] = __builtin_fmaf(wh[h], bf2f(q[h][0][e]), l0[e]); l1[e] = __builtin_fmaf(wh[h], bf2f(q[h][1][e]), l1[e]); }
    u32x4 w0 = {cvtpk(l0[0], l0[1]), cvtpk(l0[2], l0[3]), cvtpk(l0[4], l0[5]), cvtpk(l0[6], l0[7])};
    u32x4 w1 = {cvtpk(l1[0], l1[1]), cvtpk(l1[2], l1[3]), cvtpk(l1[4], l1[5]), cvtpk(l1[6], l1[7])};
    qlin0 = *reinterpret_cast<bf16x8*>(&w0); qlin1 = *reinterpret_cast<bf16x8*>(&w1); }
  const bf16* kbase = kidx + ((long)b * SEQ + qi) * 64 + kg * 8;
  unsigned T = 0u;
#pragma unroll 1
  for (int it = (NT > 4) ? 0 : 32; it <= 32; ++it) {
    const bool emit = (it == 32);
    const unsigned probe = emit ? T : (T | (0x80000000u >> it)); unsigned cnt = 0u, lo = 0u, hiw = 0u;
#pragma unroll 1
    for (int js = 4 * kq; js < 4 * NT; js += (js & 3) == 3 ? 13 : 1) {
      const bf16* kp = kbase + (long)(16 * js) * 64;
      const bf16x8 ka0 = *reinterpret_cast<const bf16x8*>(kp), ka1 = *reinterpret_cast<const bf16x8*>(kp + 32);
      f32x4 sc; IDX_SCORE(sc, ka0, ka1);
      unsigned bits = 0u;
#pragma unroll
      for (int r = 0; r < 4; ++r) bits |= (monokey(sc[r]) >= probe) ? (1u << r) : 0u;
      cnt += __builtin_popcount(bits);
      if (emit) {
        const int sub = js & 3; bits <<= (4 * kg + 16 * (sub & 1));
        if (sub < 2) lo |= bits; else hiw |= bits;
        if (sub == 3) {
          lo |= __shfl_xor(lo, 16); lo |= __shfl_xor(lo, 32); hiw |= __shfl_xor(hiw, 16); hiw |= __shfl_xor(hiw, 32);
          if (kg == 0) maskp[rowg * 128 + (js >> 2)] = (u32x2){lo, hiw};
          lo = 0u; hiw = 0u; }
      }
    }
    if (!emit) {
      cnt += __shfl_xor(cnt, 16); cnt += __shfl_xor(cnt, 32);
      if (kg == 0) cntbuf[(16 * g + qi) * 4 + kq] = cnt;
      __syncthreads();
      const u32x4 cc = *reinterpret_cast<const u32x4*>(cntbuf + (16 * g + qi) * 4);
      if (cc.x + cc.y + cc.z + cc.w >= 256u) T = probe;
      __syncthreads();
    }
  }
  if (kq == 0 && kg == 0) for (int j = NT; j <= (c | 3); ++j) maskp[rowg * 128 + j] = (u32x2){0u, 0u};
}
#undef IDX_SCORE
}

constexpr int NWAVES = 8;
#ifndef MK_N_LAUNCHES
#define MK_N_LAUNCHES 1
#endif
constexpr int N_PHASES = 7;
constexpr int N_LAUNCHES = MK_N_LAUNCHES;
static_assert(N_LAUNCHES == 1 || N_LAUNCHES == N_PHASES, "MK_N_LAUNCHES is 1 or 7");

constexpr int BATCH = 2, SEQ = 8192, DMODEL = 2048, M = BATCH * SEQ, BW = 1024  , NPACK = 13568  , NIN = 13392;
constexpr float RMS_EPS = 1e-6f;
constexpr float QSCALE = 0.08838834764831845f * 1.4426950408889634f;

constexpr size_t MiB = 1u << 20;
constexpr size_t WS_CTL = 0, CTL_ZERO_BYTES = 1 * MiB;
constexpr size_t WS_KIDX = 1 * MiB;
constexpr size_t WS_WIDX = 3 * MiB;
constexpr size_t WS_PSS  = 4 * MiB;
constexpr size_t WS_WSB  = 6 * MiB, WS_WSA = 10 * MiB, WS_WOUT = 14 * MiB;
constexpr size_t WS_MASK = 22 * MiB;
constexpr size_t WS_P9   = 38 * MiB;
constexpr size_t P9_STRIDE = (size_t)M * 1024 * 2;
constexpr size_t WS_G    = WS_P9 + 9 * P9_STRIDE;
constexpr size_t WS_END  = WS_G + (size_t)M * 4096 * 2;
constexpr size_t WS_T1   = WS_P9 + 1 * P9_STRIDE;
constexpr size_t WS_MIX  = WS_P9 + 5 * P9_STRIDE;
constexpr size_t OUT_WIN = 0, OUT_XN = 56 * MiB;
static_assert(OUT_XN >= (size_t)NPACK * DMODEL * 2 && OUT_XN + (size_t)M * DMODEL * 2 <= (size_t)M * DMODEL * 4, "d_out scratch map");
constexpr int CW_TMO = 0, CW_CODE = 1, CW_BAR = 4096;

constexpr int RING_OFF = 0, RING_BYTES = 131072;
constexpr int LDSCTL_OFF = RING_BYTES, MISC_OFF = LDSCTL_OFF + 320;
constexpr int LDS_BYTES = 147456;
static_assert(MISC_OFF + 128 <= LDS_BYTES, "LDS map");

#define GAS __attribute__((address_space(1)))
#define LAS __attribute__((address_space(3)))
typedef unsigned short bf16;
typedef unsigned v4u __attribute__((ext_vector_type(4)));
typedef float f32x4 __attribute__((ext_vector_type(4)));
typedef short bf16x8 __attribute__((ext_vector_type(8)));
typedef GAS unsigned gu32;
typedef GAS unsigned long long gu64;
#define RLX_AGENT __ATOMIC_RELAXED, __HIP_MEMORY_SCOPE_AGENT
#define LDS_WAIT() asm volatile("s_waitcnt lgkmcnt(0)" ::: "memory")
#define VM_WAIT() asm volatile("s_waitcnt vmcnt(0)" ::: "memory")
__device__ __forceinline__ unsigned long long rt() { return __builtin_amdgcn_s_memrealtime(); }
__device__ __forceinline__ unsigned f2bf(float f) { unsigned u = __builtin_bit_cast(unsigned, f); return (u + 0x7fffu + ((u >> 16) & 1u)) >> 16; }
__device__ __forceinline__ unsigned pk2(float lo, float hi) { return f2bf(lo) | (f2bf(hi) << 16); }
#define XB_TMO      128
#define XB_XCNT(j)  (256  + 64 * (j))
#define XB_XSUB(j)  (1280 + 64 * (j))
#define XB_XGEN(j)  (2304 + 64 * (j))
#define XB_TOP      3328
#define XB_TOPGEN   3392
#define XCD_BAR_WORDS 3456
#define XB_SPIN_CAP (1u << 22)

__device__ __forceinline__ unsigned xb_ld(unsigned* p)              { return __hip_atomic_load(p, __ATOMIC_RELAXED, __HIP_MEMORY_SCOPE_AGENT); }
__device__ __forceinline__ unsigned xb_add(unsigned* p, unsigned v) { return __hip_atomic_fetch_add(p, v, __ATOMIC_RELAXED, __HIP_MEMORY_SCOPE_AGENT); }
__device__ __forceinline__ unsigned xb_xcc_id() { return (unsigned)__builtin_amdgcn_s_getreg((3 << 11) | 20) & 0xFu; }
#define XB_SPIN(cond, bar) do { unsigned _sp = 0; while (cond) { __builtin_amdgcn_s_sleep(1); \
    if ((++_sp & 255u) == 0u) { if (xb_ld(&(bar)[XB_TMO])) break; if (_sp > XB_SPIN_CAP) { atomicAdd(&(bar)[XB_TMO], 1u); break; } } } } while (0)

struct XcdBarrier {
    unsigned* bar; unsigned x;
    volatile LAS unsigned* st;
};

__device__ __forceinline__ XcdBarrier xcd_barrier_post(unsigned* bar, volatile LAS unsigned* st) {
    XcdBarrier b; b.bar = bar; b.x = xb_xcc_id(); b.st = st;
    if (threadIdx.x == 0) (void)xb_add(&bar[XB_XCNT(b.x)], 1u);
    return b;
}
__device__ __forceinline__ void xcd_barrier_complete(unsigned* bar, unsigned x, unsigned& nloc, unsigned& nx) {
    const unsigned G = gridDim.x * gridDim.y * gridDim.z;
    unsigned sum, cnt, mine, sp = 0u;
    for (;;) {
        sum = 0u; cnt = 0u; mine = 0u;
#pragma unroll
        for (unsigned j = 0; j < 16; ++j) { const unsigned c = xb_ld(&bar[XB_XCNT(j)]); sum += c; cnt += (c > 0u) ? 1u : 0u; mine = (j == x) ? c : mine; }
        if (sum == G) break;
        __builtin_amdgcn_s_sleep(1);
        if ((++sp & 255u) == 0u) { if (xb_ld(&bar[XB_TMO])) break; if (sp > XB_SPIN_CAP) { atomicAdd(&bar[XB_TMO], 1u); break; } }
    }
    nloc = mine > 0u ? mine : 1u; nx = cnt > 0u ? cnt : 1u;
}

__device__ __forceinline__ void xcd_barrier(const XcdBarrier& b) {
    asm volatile("s_waitcnt vmcnt(0)" ::: "memory");
    __syncthreads();
    if (threadIdx.x == 0) {
        unsigned* bar = b.bar;
        __builtin_amdgcn_s_waitcnt(0);
        unsigned nloc = b.st[0], nx = b.st[1];
        if (nloc == 0u) { xcd_barrier_complete(bar, b.x, nloc, nx); b.st[0] = nloc; b.st[1] = nx; }
        const unsigned old = xb_add(&bar[XB_XSUB(b.x)], 1u);
        const unsigned gen = old / nloc;
        if (old + 1u == (gen + 1u) * nloc) {
            __builtin_amdgcn_fence(__ATOMIC_RELEASE, "agent");
            asm volatile("s_waitcnt vmcnt(0)" ::: "memory");
            const unsigned og = xb_add(&bar[XB_TOP], 1u);
            const unsigned tg = og / nx;
            if (og + 1u == (tg + 1u) * nx) xb_add(&bar[XB_TOPGEN], 1u);
            else XB_SPIN(xb_ld(&bar[XB_TOPGEN]) == tg, bar);
            __builtin_amdgcn_fence(__ATOMIC_ACQUIRE, "agent");
            xb_add(&bar[XB_XGEN(b.x)], 1u);
            asm volatile("s_waitcnt vmcnt(0)" ::: "memory");
        } else {
            XB_SPIN(xb_ld(&bar[XB_XGEN(b.x)]) == gen, bar);
            __builtin_amdgcn_fence(__ATOMIC_ACQUIRE, "agent");
            asm volatile("s_waitcnt vmcnt(0)" ::: "memory");
        }
    }
    __syncthreads();
}
struct Frame {
    LAS unsigned char* lds;
    volatile LAS unsigned* MISC;
    gu32* ctl;
    int tid, lane, wave;
    int vcu, G;
    const float *x, *gain, *w_in, *w_sb, *w_sa, *w_out, *fgain; float* out;
    unsigned char *ws, *outb;
};
__device__ __forceinline__ float wave_sum(float v) {
#pragma unroll
    for (int o = 1; o < 64; o <<= 1) v += __shfl_xor(v, o);
    return v;
}
template <class CMap>
__device__ __forceinline__ void p0_transpose_item(const float* W, int ldw, int K, bf16* WT, const float* rowgain, const CMap& cm, LAS float* scr, int kb, int nb, int lane) {
    const int k0 = 64 * kb, n0 = 32 * nb, n = n0 + (lane & 31); float sc; const int cs = cm(n, sc);
#pragma unroll 8
    for (int i = 0; i < 32; ++i) { const int kk = 2 * i + (lane >> 5); float v = 0.f;
        if (cs >= 0) { v = W[(size_t)(k0 + kk) * ldw + cs] * sc; if (rowgain) v *= rowgain[k0 + kk]; }
        scr[kk * 33 + (lane & 31)] = v; }
    LDS_WAIT(); asm volatile("" ::: "memory");
    const int c = lane & 7;
#pragma unroll
    for (int j = 0; j < 4; ++j) { const int nn = (lane >> 3) + 8 * j; const LAS float* s = scr + (8 * c) * 33 + nn;
        v4u o; o.x = pk2(s[0 * 33], s[1 * 33]); o.y = pk2(s[2 * 33], s[3 * 33]); o.z = pk2(s[4 * 33], s[5 * 33]); o.w = pk2(s[6 * 33], s[7 * 33]);
        *(GAS v4u*)(WT + (size_t)(n0 + nn) * K + k0 + 8 * c) = o; }
    LDS_WAIT(); asm volatile("" ::: "memory");
}
struct CMapWin {
    __device__ __forceinline__ int operator()(int n, float& sc) const {
        sc = 1.f;
        if (n < 9216) { if (n < 1024 || (n >= 4096 && n < 5120)) sc = QSCALE; else if (n >= 8192) sc = 0.125f; return n; }
        if (n < 13312) return n + 80;
        if (n < 13392) { if (n >= 13376) sc = 0.25f; return n - 13312 + 9216; }
        return -1;
    }
};
struct CMapId { __device__ __forceinline__ int operator()(int n, float& sc) const { sc = 1.f; return n; } };
__device__ __forceinline__ void rms_row_to_bf16(const float* xrow, bf16* orow, int lane) {
    const GAS f32x4* xr = (const GAS f32x4*)xrow + lane;
    f32x4 v[8]; float s = 0.f;
#pragma unroll
    for (int j = 0; j < 8; ++j) { v[j] = xr[64 * j]; s += (v[j].x * v[j].x + v[j].y * v[j].y) + (v[j].z * v[j].z + v[j].w * v[j].w); }
    const float rstd = 1.f / sqrtf(wave_sum(s) * (1.f / DMODEL) + RMS_EPS);
    GAS unsigned long long* o8 = (GAS unsigned long long*)orow + lane;
#pragma unroll
    for (int j = 0; j < 8; ++j) o8[64 * j] = (unsigned long long)pk2(v[j].x * rstd, v[j].y * rstd) | ((unsigned long long)pk2(v[j].z * rstd, v[j].w * rstd) << 32);
}
__device__ __forceinline__ void p0_prologue(Frame& F) {
    LAS float* scr = (LAS float*)(F.lds + RING_OFF + F.wave * 16384);
    const int gw = F.vcu * NWAVES + F.wave, NGW = F.G * NWAVES;
    constexpr int I_IN = (DMODEL / 64) * (NPACK / 32), I_B = (BW / 64) * (DMODEL / 32), I_O = (DMODEL / 64) * (DMODEL / 32);
    constexpr int NITEMS = I_IN + 2 * I_B + I_O;
    bf16* Win_t = (bf16*)(F.outb + OUT_WIN);
    for (int it = gw; it < NITEMS; it += NGW) {
        int r = it;
        if (r < I_IN) { p0_transpose_item(F.w_in, NIN, DMODEL, Win_t, F.gain, CMapWin{}, scr, r / (NPACK / 32), r % (NPACK / 32), F.lane); continue; } r -= I_IN;
        if (r < I_B) { p0_transpose_item(F.w_sb, DMODEL, BW, (bf16*)(F.ws + WS_WSB), nullptr, CMapId{}, scr, r / (DMODEL / 32), r % (DMODEL / 32), F.lane); continue; } r -= I_B;
        if (r < I_B) { p0_transpose_item(F.w_sa, DMODEL, BW, (bf16*)(F.ws + WS_WSA), nullptr, CMapId{}, scr, r / (DMODEL / 32), r % (DMODEL / 32), F.lane); continue; } r -= I_B;
        p0_transpose_item(F.w_out, DMODEL, DMODEL, (bf16*)(F.ws + WS_WOUT), nullptr, CMapId{}, scr, r / (DMODEL / 32), r % (DMODEL / 32), F.lane);
    }
    bf16* XN = (bf16*)(F.outb + OUT_XN);
    for (int m = gw; m < M; m += NGW) rms_row_to_bf16(F.x + (size_t)m * DMODEL, XN + (size_t)m * DMODEL, F.lane);
}
__device__ __forceinline__ void p6_final_norm(Frame& F) {
    const int gw = F.vcu * NWAVES + F.wave, NGW = F.G * NWAVES;
    const float* pss = (const float*)(F.ws + WS_PSS);
    f32x4 gv[8];
#pragma unroll
    for (int j = 0; j < 8; ++j) gv[j] = ((const GAS f32x4*)F.fgain)[F.lane + 64 * j];
    for (int m = gw; m < M; m += NGW) {
        const float part = (F.lane < 32) ? pss[(size_t)m * 32 + F.lane] : 0.f;
        const float rstd = 1.f / sqrtf(wave_sum(part) * (1.f / DMODEL) + RMS_EPS);
        GAS f32x4* hr = (GAS f32x4*)(F.out + (size_t)m * DMODEL) + F.lane;
#pragma unroll
        for (int j = 0; j < 8; ++j) { f32x4 v = hr[64 * j]; v = v * rstd * gv[j]; hr[64 * j] = v; }
    }
}

struct Args { const float* in[7]; float* out; unsigned char* ws; int ph_lo, ph_hi, li, pad; };
__global__ void __launch_bounds__(NWAVES * 64, 2) hsd_fwd(Args args) {
    extern __shared__ __attribute__((aligned(16))) unsigned char lds[];
    Frame F;
    F.lds = (LAS unsigned char*)lds;
    F.MISC = (volatile LAS unsigned*)(F.lds + MISC_OFF);
    F.tid = threadIdx.x; F.lane = F.tid & 63; F.wave = __builtin_amdgcn_readfirstlane(F.tid >> 6);
    F.G = gridDim.x; { const int bx = blockIdx.x; F.vcu = (F.G % 8 == 0) ? (bx % 8) * (F.G / 8) + bx / 8 : bx; }
    F.ws = args.ws; F.outb = (unsigned char*)args.out; F.out = args.out;
    F.ctl = (gu32*)(F.ws + WS_CTL);
    F.x = args.in[0]; F.gain = args.in[1]; F.w_in = args.in[2]; F.w_sb = args.in[3]; F.w_sa = args.in[4]; F.w_out = args.in[5]; F.fgain = args.in[6];
    for (int u = F.tid; u < (LDS_BYTES - LDSCTL_OFF) / 4; u += NWAVES * 64) ((LAS unsigned*)(F.lds + LDSCTL_OFF))[u] = 0u;
    __syncthreads();
    XcdBarrier bar; bar.bar = (unsigned*)(F.ctl + CW_BAR); bar.x = 0; bar.st = nullptr;
    if (N_LAUNCHES == 1) bar = xcd_barrier_post((unsigned*)(F.ctl + CW_BAR), F.MISC + 8);
#define GRID_BAR() do { if (N_LAUNCHES == 1) { xcd_barrier(bar); } } while (0)
    const int lo = args.ph_lo, hi = args.ph_hi;
#ifndef PHASE_MASK
#define PHASE_MASK 0x7f
#endif
#define IN(k) ((((PHASE_MASK) >> (k)) & 1) && lo <= (k) && (k) < hi)
#define BOTH(k) (IN(k) && IN((k) + 1))
    bf16* P9 = (bf16*)(F.ws + WS_P9);
    bf16* Gt = (bf16*)(F.ws + WS_G);
    const size_t PS = (size_t)M * 1024;

    if (IN(0)) { p0_prologue(F); if (BOTH(0)) GRID_BAR(); }

    if (IN(1)) {
        pg8::Gemm g{(const bf16*)(F.outb + OUT_XN), (const bf16*)(F.outb + OUT_WIN), M, NPACK, DMODEL}; pg8::StaticOrder S; S.init(M, NPACK, F.G, (int)blockIdx.x);
        pg8::EpiProj E{P9, Gt, (bf16*)(F.ws + WS_KIDX), (float*)(F.ws + WS_WIDX)};
        pg8::gemm_phase<pg8::EpiProj, pg8::StaticOrder, true, true>(F.lds + RING_OFF, g, S, E);
        if (BOTH(1)) GRID_BAR();
    }

    if (IN(2)) {
#ifndef NO_IDX
        for (int v2 = F.vcu; v2 < 512; v2 += F.G) { const int v = v2 & 255, b = (v >> 7) & 1, p = (v & 127) >> 1, hf = v & 1, c = (v2 < 256) ? p : 127 - p;
            idx::idx_unit(b, c, hf, P9 + 8 * PS, (const bf16*)(F.ws + WS_KIDX), (const float*)(F.ws + WS_WIDX), (idx::u32x2*)(F.ws + WS_MASK), (char*)lds + RING_OFF);
            __syncthreads(); }
#endif
#ifndef NO_SB
        for (int u = F.vcu; u < 512; u += F.G) { const int b = u >> 8, h = (u >> 5) & 7, qb = u & 31;
            att::sb_unit(b, h, qb, P9 + 0 * PS, P9 + 1 * PS, P9 + 2 * PS, P9 + 3 * PS, (char*)lds + RING_OFF); }
#endif
        if (BOTH(2)) GRID_BAR();
    }

    if (IN(3)) {
        for (int u = F.vcu; u < 256; u += F.G) { const int bh = u >> 4, s = u & 15, b = bh >> 3, h = bh & 7;
            att::sa_unit(b, h, 31 - s, P9 + 4 * PS, P9 + 5 * PS, P9 + 6 * PS, P9 + 7 * PS, (const att::u32x2*)(F.ws + WS_MASK), (char*)lds + RING_OFF);
            att::sa_unit(b, h, s, P9 + 4 * PS, P9 + 5 * PS, P9 + 6 * PS, P9 + 7 * PS, (const att::u32x2*)(F.ws + WS_MASK), (char*)lds + RING_OFF); }
        if (BOTH(3)) GRID_BAR();
    }

    if (IN(4)) {
        pg8::StaticOrder S; S.init(M, DMODEL, F.G, (int)blockIdx.x);
        { pg8::Gemm g{P9 + 0 * PS, (const bf16*)(F.ws + WS_WSB), M, DMODEL, BW};
          pg8::EpiGate<0> E{Gt, 0, nullptr, (bf16*)(F.ws + WS_T1)};
          pg8::gemm_phase<pg8::EpiGate<0>, pg8::StaticOrder, true, true>(F.lds + RING_OFF, g, S, E); }
        { pg8::Gemm g{P9 + 4 * PS, (const bf16*)(F.ws + WS_WSA), M, DMODEL, BW};
          pg8::EpiGate<1> E{Gt, 2048, (const bf16*)(F.ws + WS_T1), (bf16*)(F.ws + WS_MIX)};
          pg8::gemm_phase<pg8::EpiGate<1>, pg8::StaticOrder, true, true>(F.lds + RING_OFF, g, S, E); }
        if (BOTH(4)) GRID_BAR();
    }

    if (IN(5)) {
        pg8::Gemm g{(const bf16*)(F.ws + WS_MIX), (const bf16*)(F.ws + WS_WOUT), M, DMODEL, DMODEL}; pg8::StaticOrder S; S.init(M, DMODEL, F.G, (int)blockIdx.x);
        pg8::EpiOut E{F.x, F.out, (float*)(F.ws + WS_PSS)};
        pg8::gemm_phase<pg8::EpiOut, pg8::StaticOrder, true, true>(F.lds + RING_OFF, g, S, E);
        if (BOTH(5)) GRID_BAR();
    }

    if (IN(6)) { p6_final_norm(F); }
#undef IN
#undef BOTH
#undef GRID_BAR
}

extern "C" void kernel_launch(void* const* d_in, const int* in_sizes, int n_in, void* d_out, int out_size, void* d_ws, size_t ws_size, hipStream_t stream) {
    static int grid = 0;
    if (grid == 0) {
        if (n_in != 7 || in_sizes[0] != M * DMODEL || out_size != M * DMODEL || ws_size < WS_END) {
            fprintf(stderr, "kernel_launch: built for 7 inputs, x and out of %d floats, >= %zu bytes of workspace; got n_in %d, in0 %d, out %d, ws %zu; nothing launched\n", M * DMODEL, (size_t)WS_END, n_in, n_in > 0 ? in_sizes[0] : -1, out_size, ws_size); grid = -1; return; }
        int dev = 0, cus = 0, per_cu = 0;
        if (hipGetDevice(&dev) != hipSuccess || hipDeviceGetAttribute(&cus, hipDeviceAttributeMultiprocessorCount, dev) != hipSuccess) { fprintf(stderr, "kernel_launch: device query failed\n"); grid = -1; return; }
        if (hipFuncSetAttribute((const void*)hsd_fwd, hipFuncAttributeMaxDynamicSharedMemorySize, LDS_BYTES) != hipSuccess) { fprintf(stderr, "kernel_launch: hipFuncSetAttribute failed\n"); grid = -1; return; }
        if (hipOccupancyMaxActiveBlocksPerMultiprocessor(&per_cu, (const void*)hsd_fwd, NWAVES * 64, LDS_BYTES) != hipSuccess || per_cu < 1)
            fprintf(stderr, "kernel_launch: note: occupancy query reports %d workgroups per CU\n", per_cu);
        (void)hipGetLastError();
        grid = cus;
    }
    if (grid < 0) return;
    if (hipMemsetAsync((char*)d_ws + WS_CTL, 0, CTL_ZERO_BYTES, stream) != hipSuccess) { fprintf(stderr, "kernel_launch: hipMemsetAsync failed\n"); return; }
    Args a{};
    for (int i = 0; i < 7; ++i) a.in[i] = (const float*)d_in[i];
    a.out = (float*)d_out; a.ws = (unsigned char*)d_ws;
    for (int li = 0; li < N_LAUNCHES; ++li) {
        a.ph_lo = (N_LAUNCHES == 1) ? 0 : li; a.ph_hi = (N_LAUNCHES == 1) ? N_PHASES : li + 1; a.li = li;
        hipLaunchKernelGGL(hsd_fwd, dim3(grid), dim3(NWAVES * 64), LDS_BYTES, stream, a);
        const hipError_t le = hipPeekAtLastError();
        if (le != hipSuccess) { fprintf(stderr, "kernel_launch: launch %d failed: %s\n", li, hipGetErrorName(le)); break; }
    }
}
```

```cpp
#define PROBE_MODE 0
#include <hip/hip_runtime.h>
#include <hip/hip_bf16.h>
#include <cstdio>
#include <cstdint>
namespace pg8 {
#define PG8_LAS __attribute__((address_space(3)))
typedef unsigned short bf16_t;
typedef short bf16x8 __attribute__((ext_vector_type(8)));
typedef float f32x4 __attribute__((ext_vector_type(4)));
typedef unsigned u32x4 __attribute__((ext_vector_type(4)));
constexpr int BM = 256, BK = 64, HALF = 128, HTB = HALF * BK * 2  , STAGE_BYTES = 8 * HTB, NXCD = 8, WGM = 8;

__host__ __device__ __forceinline__ int lds_byte(int r, int c) { const int st = (r >> 4) * 2 + (c >> 5), rr = r & 15, cc = c & 31, ob = rr * 64 + cc * 2; return st * 1024 + (ob ^ (((ob >> 9) & 1) << 5)); }
__host__ __device__ __forceinline__ void stage_rc(int b, int& R, int& C) { const int st = b / 1024, sb = b % 1024, swz = sb ^ (((sb >> 9) & 1) << 5); R = (st >> 1) * 16 + swz / 64; C = (st & 1) * 32 + (swz % 64) / 2; }
__host__ __device__ __forceinline__ int perm32(int rho) { const int n = rho >> 4, i = rho & 15; return 8 * (i >> 2) + 4 * n + (i & 3); }

struct Unit { int pm, pn; };
struct Gemm { const bf16_t* A; const bf16_t* Bt; int M, N, K; };

struct StaticOrder {
    int nM, nN, nwg, G, c;
    __host__ __device__ void init(int M, int N, int G_, int c_) { nM = M / BM; nN = N / BM; nwg = nM * nN; G = G_; c = c_; }
    __host__ __device__ bool next(int i, Unit& u) const {
        const long L = (long)i * G + c; if (L >= nwg) return false;
        int wgid = (int)L; { const int q = nwg / NXCD, r = nwg % NXCD, xcd = wgid % NXCD, off = wgid / NXCD; wgid = (xcd < r ? xcd * (q + 1) : r * (q + 1) + (xcd - r) * q) + off; }
        const int nig = WGM * nN, gid = wgid / nig, fm = gid * WGM, gsz = (nM - fm) < WGM ? (nM - fm) : WGM;
        u.pm = fm + ((wgid % nig) % gsz); u.pn = (wgid % nig) / gsz; return true;
    }
    __device__ __forceinline__ void a_ready(const Unit&) const {}
    __device__ __forceinline__ void done(const Unit&) const {}
};

typedef float cvt_f32x2_t __attribute__((ext_vector_type(2))); typedef __bf16 cvt_bf16x2_t __attribute__((ext_vector_type(2)));
__device__ __forceinline__ unsigned cvt_pk_bf16(float lo, float hi) { cvt_f32x2_t v = {lo, hi}; cvt_bf16x2_t b = __builtin_convertvector(v, cvt_bf16x2_t); return __builtin_bit_cast(unsigned, b); }
typedef float f32x2 __attribute__((ext_vector_type(2)));
constexpr int EM = 16384;
#ifndef PROBE_MODE
#define PROBE_MODE 0
#endif
__device__ __forceinline__ float bf_lo(unsigned w) { return __uint_as_float(w << 16); }
__device__ __forceinline__ float bf_hi(unsigned w) { return __uint_as_float(w & 0xffff0000u); }
__device__ __forceinline__ float sigmoid_f(float v) { return __builtin_amdgcn_rcpf(1.0f + __builtin_amdgcn_exp2f(-1.4426950408889634f * v)); }
__device__ __forceinline__ float silu_f(float v) { return v * sigmoid_f(v); }
template <int ACT> __device__ __forceinline__ f32x4 act4(f32x4 v) {
    if (ACT == 1) { v[0] = silu_f(v[0]); v[1] = silu_f(v[1]); v[2] = silu_f(v[2]); v[3] = silu_f(v[3]); }
    if (ACT == 2) { v[0] = sigmoid_f(v[0]); v[1] = sigmoid_f(v[1]); v[2] = sigmoid_f(v[2]); v[3] = sigmoid_f(v[3]); }
    return v;
}
struct EpiProj {
    static constexpr bool PERM = true, AFTER_DRAIN = false;
    bf16_t* P9; bf16_t* G; bf16_t* kidx; float* widx;
    template <int ACT> __device__ __forceinline__ void tile(const f32x4 (&acc)[2][2][4][2], bf16_t* base, int ldc, int row0, int col0) const {
#pragma unroll
        for (int ai = 0; ai < 2; ++ai)
#pragma unroll
            for (int m = 0; m < 4; ++m) { bf16_t* rowp = base + (size_t)(row0 + ai * HALF + m * 16) * ldc + col0;
#pragma unroll
                for (int bj = 0; bj < 2; ++bj) { const f32x4 v0 = act4<ACT>(acc[ai][bj][m][0]), v1 = act4<ACT>(acc[ai][bj][m][1]);
                    u32x4 w; w.x = cvt_pk_bf16(v0[0], v0[1]); w.y = cvt_pk_bf16(v0[2], v0[3]); w.z = cvt_pk_bf16(v1[0], v1[1]); w.w = cvt_pk_bf16(v1[2], v1[3]);
                    *(u32x4*)(rowp + bj * HALF) = w; } }
    }
    __device__ __forceinline__ void operator()(const f32x4 (&acc)[2][2][4][2], const Unit& u, int wr, int wc, int fr, int fq) const {
        const int pn = u.pn, row0 = u.pm * BM + wr * 64 + fr;
        if (pn < 36) { const int t = pn >> 2; bf16_t* base = P9 + (size_t)t * ((size_t)EM * 1024); const int col0 = (pn & 3) * 256 + wc * 32 + 8 * fq;
            if (t == 3 || t == 7) tile<1>(acc, base, 1024, row0, col0); else tile<0>(acc, base, 1024, row0, col0); }
        else if (pn < 52) { tile<2>(acc, G, 4096, row0, (pn - 36) * 256 + wc * 32 + 8 * fq); }
        else {
            if (wc < 2) {
#pragma unroll
                for (int ai = 0; ai < 2; ++ai)
#pragma unroll
                    for (int m = 0; m < 4; ++m) { const f32x4 v0 = acc[ai][0][m][0], v1 = acc[ai][0][m][1];
                        u32x4 w; w.x = cvt_pk_bf16(v0[0], v0[1]); w.y = cvt_pk_bf16(v0[2], v0[3]); w.z = cvt_pk_bf16(v1[0], v1[1]); w.w = cvt_pk_bf16(v1[2], v1[3]);
                        *(u32x4*)(kidx + (size_t)(row0 + ai * HALF + m * 16) * 64 + wc * 32 + 8 * fq) = w; }
            } else if (wc == 2 && fq < 2) {
#pragma unroll
                for (int ai = 0; ai < 2; ++ai)
#pragma unroll
                    for (int m = 0; m < 4; ++m) { float* p = widx + (size_t)(row0 + ai * HALF + m * 16) * 16 + 8 * fq;
                        *(f32x4*)p = acc[ai][0][m][0]; *(f32x4*)(p + 4) = acc[ai][0][m][1]; }
            }
        }
    }
};
template <int MODE> struct EpiGate {
    static constexpr bool PERM = true, AFTER_DRAIN = false;
    const bf16_t* G; int gcol0; const bf16_t* Tin; bf16_t* Tout;
    __device__ __forceinline__ void operator()(const f32x4 (&acc)[2][2][4][2], const Unit& u, int wr, int wc, int fr, int fq) const {
        const int row0 = u.pm * BM + wr * 64 + fr, col0 = u.pn * BM + wc * 32 + 8 * fq;
#pragma unroll
        for (int ai = 0; ai < 2; ++ai)
#pragma unroll
            for (int m = 0; m < 4; ++m) { const size_t row = (size_t)(row0 + ai * HALF + m * 16);
#pragma unroll
                for (int bj = 0; bj < 2; ++bj) {
                    const u32x4 g = *(const u32x4*)(G + row * 4096 + (PROBE_MODE == 17 ? 2048 - gcol0 : gcol0) + col0 + bj * HALF);
                    f32x4 v0 = acc[ai][bj][m][0], v1 = acc[ai][bj][m][1];
                    if ((PROBE_MODE == 3 && MODE == 0) || (PROBE_MODE == 2 && MODE == 1)) { v0 = v0 * 0.f; v1 = v1 * 0.f; }
                    if (PROBE_MODE == 8 && MODE == 1) { v0 = v0 * 0.5f; v1 = v1 * 0.5f; }
                    if (PROBE_MODE == 10 || (PROBE_MODE == 14 && MODE == 1) || (PROBE_MODE == 15 && MODE == 0)) { v0 = v0 * 0.5f; v1 = v1 * 0.5f; } else {
                    float gg[8] = {bf_lo(g.x), bf_hi(g.x), bf_lo(g.y), bf_hi(g.y), bf_lo(g.z), bf_hi(g.z), bf_lo(g.w), bf_hi(g.w)};
                    if (PROBE_MODE == 20) { for (int e_ = 0; e_ < 8; ++e_) if (!(gg[e_] > 0.02f && gg[e_] < 0.98f)) gg[e_] = 0.5f; }
                    if (PROBE_MODE == 21) { for (int e_ = 0; e_ < 8; ++e_) if (!(gg[e_] >= 0.0f && gg[e_] <= 1.0f)) gg[e_] = 0.5f; }
                    if (PROBE_MODE == 25 && (gcol0 + col0 + bj * HALF) >= 3840) { for (int e_ = 0; e_ < 8; ++e_) if (!(gg[e_] >= 0.0f && gg[e_] <= 1.0f)) gg[e_] = 0.5f; }
                    if (PROBE_MODE == 26 && (gcol0 + col0 + bj * HALF) < 2048) { for (int e_ = 0; e_ < 8; ++e_) if (!(gg[e_] >= 0.0f && gg[e_] <= 1.0f)) gg[e_] = 0.5f; }
                    if (PROBE_MODE == 27 && row < 8192) { for (int e_ = 0; e_ < 8; ++e_) if (!(gg[e_] >= 0.0f && gg[e_] <= 1.0f)) gg[e_] = 0.5f; }
                    if (PROBE_MODE == 28 && (row & 255) < 128) { for (int e_ = 0; e_ < 8; ++e_) if (!(gg[e_] >= 0.0f && gg[e_] <= 1.0f)) gg[e_] = 0.5f; }
                    if (PROBE_MODE == 22) { for (int e_ = 0; e_ < 8; ++e_) if (!(gg[e_] > 1e-4f)) gg[e_] = 0.5f; }
                    v0[0] *= gg[0]; v0[1] *= gg[1]; v0[2] *= gg[2]; v0[3] *= gg[3];
                    v1[0] *= gg[4]; v1[1] *= gg[5]; v1[2] *= gg[6]; v1[3] *= gg[7]; }
                    if (MODE == 1) { const u32x4 t = *(const u32x4*)(Tin + row * 2048 + col0 + bj * HALF);
                        v0[0] += bf_lo(t.x); v0[1] += bf_hi(t.x); v0[2] += bf_lo(t.y); v0[3] += bf_hi(t.y);
                        v1[0] += bf_lo(t.z); v1[1] += bf_hi(t.z); v1[2] += bf_lo(t.w); v1[3] += bf_hi(t.w); }
                    u32x4 w; w.x = cvt_pk_bf16(v0[0], v0[1]); w.y = cvt_pk_bf16(v0[2], v0[3]); w.z = cvt_pk_bf16(v1[0], v1[1]); w.w = cvt_pk_bf16(v1[2], v1[3]);
                    *(u32x4*)(Tout + row * 2048 + col0 + bj * HALF) = w; }
                asm volatile("" ::: "memory"); }
    }
};
struct EpiOut {
    static constexpr bool PERM = false, AFTER_DRAIN = false;
    const float* x; float* h; float* pss;
    __device__ __forceinline__ void operator()(const f32x4 (&acc)[2][2][4][2], const Unit& u, int wr, int wc, int fr, int fq) const {
        const int row0 = u.pm * BM + wr * 64 + fr, col0 = u.pn * BM + wc * 32 + 4 * fq;
#pragma unroll
        for (int ai = 0; ai < 2; ++ai)
#pragma unroll
            for (int m = 0; m < 4; ++m) { const size_t row = (size_t)(row0 + ai * HALF + m * 16); float ss = 0.f;
#pragma unroll
                for (int bj = 0; bj < 2; ++bj)
#pragma unroll
                    for (int n = 0; n < 2; ++n) { const size_t off = row * 2048 + col0 + bj * HALF + n * 16;
                        const f32x4 hv = *(const f32x4*)(x + off) + (PROBE_MODE == 1 ? acc[ai][bj][m][n] * 0.f : acc[ai][bj][m][n]); *(f32x4*)(h + off) = hv;
                        ss += (hv[0] * hv[0] + hv[1] * hv[1]) + (hv[2] * hv[2] + hv[3] * hv[3]); }
                ss += __shfl_xor(ss, 16); ss += __shfl_xor(ss, 32);
                if (fq == 0) pss[row * 32 + u.pn * 4 + wc] = ss;
                asm volatile("" ::: "memory"); }
    }
};

template <class Epi, class Sched, bool ALIGN_EPI = false, bool SP2 = false>
__device__ __forceinline__ void gemm_phase(PG8_LAS unsigned char* lds, const Gemm g, const Sched& S, const Epi& E, const int kwave) {
    const int lane = (int)__builtin_amdgcn_mbcnt_hi(~0u, __builtin_amdgcn_mbcnt_lo(~0u, 0u)), wid = kwave, tid = wid * 64 + lane, wr = wid >> 2, wc = wid & 3, fr = lane & 15, fq = lane >> 4;
    const int K = g.K, nt = K / BK;
    unsigned voffA[2], voffB[2];
#pragma unroll
    for (int i = 0; i < 2; ++i) { int R, C; stage_rc(tid * 16 + i * 8192, R, C); const int Rb = Epi::PERM ? ((R & ~31) + perm32(R & 31)) : R;
        voffA[i] = (unsigned)(R * K + C) * 2u; voffB[i] = (unsigned)(Rb * K + C) * 2u; }
    const size_t kstep = (size_t)(BK * 2);
    const size_t hstep = (size_t)HALF * K * 2;
    const size_t tstep = 2 * hstep;
    const unsigned ldsw = (unsigned)wid * 1024u;
    const int aoff = lds_byte(wr * 64 + fr, fq * 8), boff = lds_byte(wc * 32 + fr, fq * 8);
#define PG8_SA(b, h) (((b) * 2 + (h)) * HTB)
#define PG8_SB(b, h) ((4 + (b) * 2 + (h)) * HTB)
#define PG8_STAGE(bufoff, gbase, voff) do { _Pragma("unroll") for (int _i = 0; _i < 2; ++_i) \
        __builtin_amdgcn_global_load_lds((const unsigned*)((const char*)(gbase) + (voff)[_i]), (PG8_LAS unsigned*)(lds + (bufoff) + ldsw + _i * 8192), 16, 0, 0); } while (0)
#define PG8_LDA(dst, b, h) do { _Pragma("unroll") for (int m = 0; m < 4; ++m) _Pragma("unroll") for (int k = 0; k < 2; ++k) dst[m][k] = *(const PG8_LAS bf16x8*)(lds + PG8_SA(b, h) + aoff + m * 2048 + k * 1024); } while (0)
#define PG8_LDB(dst, b, h) do { _Pragma("unroll") for (int n = 0; n < 2; ++n) _Pragma("unroll") for (int k = 0; k < 2; ++k) dst[n][k] = *(const PG8_LAS bf16x8*)(lds + PG8_SB(b, h) + boff + n * 2048 + k * 1024); } while (0)
#define PG8_MMA(ai, bj, At, Bt) do { __builtin_amdgcn_s_setprio(1); _Pragma("unroll") for (int m = 0; m < 4; ++m) _Pragma("unroll") for (int n = 0; n < 2; ++n) _Pragma("unroll") for (int k = 0; k < 2; ++k) \
        acc[ai][bj][m][n] = __builtin_amdgcn_mfma_f32_16x16x32_bf16(Bt[n][k], At[m][k], acc[ai][bj][m][n], 0, 0, 0); __builtin_amdgcn_s_setprio(0); } while (0)
#define PG8_WAIT_V(n) asm volatile("s_waitcnt vmcnt(" #n ")" ::: "memory")
#define PG8_WAIT_L(n) asm volatile("s_waitcnt lgkmcnt(" #n ")" ::: "memory")
#define PG8_BAR __builtin_amdgcn_s_barrier()
#define PG8_SCHED __builtin_amdgcn_sched_barrier(0)
    Unit cur, nxt; int ui = 0;
    if (!S.next(0, cur)) return;
    f32x4 acc[2][2][4][2];
#pragma unroll
    for (int a = 0; a < 2; ++a)
#pragma unroll
        for (int b = 0; b < 2; ++b)
#pragma unroll
            for (int m = 0; m < 4; ++m)
#pragma unroll
                for (int n = 0; n < 2; ++n) acc[a][b][m][n] = (f32x4){0.f, 0.f, 0.f, 0.f};
    bf16x8 At[4][2], B0[2][2], B1[2][2];
    const char* cA = (const char*)g.A + (size_t)cur.pm * tstep; const char* cB = (const char*)g.Bt + (size_t)cur.pn * tstep;
    S.a_ready(cur);
    if constexpr (SP2) {
        PG8_STAGE(PG8_SB(0, 0), cB, voffB); PG8_STAGE(PG8_SB(0, 1), cB + hstep, voffB); PG8_STAGE(PG8_SA(0, 0), cA, voffA); PG8_STAGE(PG8_SA(0, 1), cA + hstep, voffA);
        if (wr == 1) PG8_BAR;
        PG8_WAIT_V(2); PG8_BAR;
        PG8_STAGE(PG8_SB(1, 0), cB + kstep, voffB); PG8_STAGE(PG8_SA(1, 0), cA + kstep, voffA); PG8_STAGE(PG8_SB(1, 1), cB + hstep + kstep, voffB);
        PG8_WAIT_V(6); PG8_BAR;
    } else {
        PG8_STAGE(PG8_SB(0, 0), cB, voffB); PG8_STAGE(PG8_SA(0, 0), cA, voffA); PG8_STAGE(PG8_SB(0, 1), cB + hstep, voffB); PG8_STAGE(PG8_SA(0, 1), cA + hstep, voffA);
        if (wr == 1) PG8_BAR;
        PG8_WAIT_V(4); PG8_BAR;
        PG8_STAGE(PG8_SB(1, 0), cB + kstep, voffB); PG8_STAGE(PG8_SA(1, 0), cA + kstep, voffA); PG8_STAGE(PG8_SB(1, 1), cB + hstep + kstep, voffB);
        PG8_WAIT_V(6); PG8_BAR;
    }
    for (;;) {
        const bool has_next = S.next(ui + 1, nxt);
        const char* nA = has_next ? (const char*)g.A + (size_t)nxt.pm * tstep : cA; const char* nB = has_next ? (const char*)g.Bt + (size_t)nxt.pn * tstep : cB;
        for (int t = 0; t < nt; t += 2) {
            const bool last = (t == nt - 2);
            const char* a1 = cA + (size_t)(t + 1) * kstep;
            const char* a2 = last ? nA : cA + (size_t)(t + 2) * kstep; const char* b2 = last ? nB : cB + (size_t)(t + 2) * kstep;
            const char* a3 = a2 + kstep; const char* b3 = b2 + kstep;
            if (last && has_next) S.a_ready(nxt);
            if constexpr (SP2) {
            PG8_LDB(B0, 0, 0); PG8_LDB(B1, 0, 1); PG8_SCHED; PG8_LDA(At, 0, 0); PG8_STAGE(PG8_SA(1, 1), a1 + hstep, voffA);
            PG8_WAIT_V(8); PG8_WAIT_L(0); PG8_BAR; PG8_MMA(0, 0, At, B0); PG8_MMA(0, 1, At, B1); PG8_BAR; PG8_SCHED;
            PG8_LDA(At, 0, 1); PG8_STAGE(PG8_SB(0, 0), b2, voffB); PG8_STAGE(PG8_SB(0, 1), b2 + hstep, voffB); PG8_STAGE(PG8_SA(0, 0), a2, voffA);
            PG8_WAIT_V(8); PG8_WAIT_L(0); PG8_BAR; PG8_MMA(1, 0, At, B0); PG8_MMA(1, 1, At, B1); PG8_BAR; PG8_SCHED;
            PG8_LDB(B0, 1, 0); PG8_LDB(B1, 1, 1); PG8_SCHED; PG8_LDA(At, 1, 0); PG8_STAGE(PG8_SA(0, 1), a2 + hstep, voffA);
            PG8_WAIT_V(8); PG8_WAIT_L(0); PG8_BAR; PG8_MMA(0, 0, At, B0); PG8_MMA(0, 1, At, B1); PG8_BAR; PG8_SCHED;
            PG8_LDA(At, 1, 1); PG8_STAGE(PG8_SB(1, 0), b3, voffB); PG8_STAGE(PG8_SB(1, 1), b3 + hstep, voffB); PG8_STAGE(PG8_SA(1, 0), a3, voffA);
            PG8_WAIT_V(8); PG8_WAIT_L(0); PG8_BAR; PG8_MMA(1, 0, At, B0); PG8_MMA(1, 1, At, B1); PG8_BAR; PG8_SCHED;
            } else {
            PG8_LDB(B0, 0, 0); PG8_SCHED; PG8_LDA(At, 0, 0); PG8_STAGE(PG8_SA(1, 1), a1 + hstep, voffA);
            PG8_WAIT_L(8); PG8_BAR; PG8_WAIT_L(0); PG8_MMA(0, 0, At, B0); PG8_BAR; PG8_SCHED;
            PG8_LDB(B1, 0, 1); PG8_STAGE(PG8_SB(0, 0), b2, voffB);
            PG8_BAR; PG8_WAIT_L(0); PG8_MMA(0, 1, At, B1); PG8_BAR;
            PG8_LDA(At, 0, 1); PG8_STAGE(PG8_SA(0, 0), a2, voffA);
            PG8_BAR; PG8_WAIT_L(0); PG8_MMA(1, 0, At, B0); PG8_BAR; PG8_SCHED;
            PG8_STAGE(PG8_SB(0, 1), b2 + hstep, voffB);
            PG8_WAIT_V(6); PG8_BAR; PG8_MMA(1, 1, At, B1); PG8_BAR;
            PG8_LDB(B0, 1, 0); PG8_SCHED; PG8_LDA(At, 1, 0); PG8_STAGE(PG8_SA(0, 1), a2 + hstep, voffA);
            PG8_WAIT_L(8); PG8_BAR; PG8_WAIT_L(0); PG8_MMA(0, 0, At, B0); PG8_BAR; PG8_SCHED;
            PG8_LDB(B1, 1, 1); PG8_STAGE(PG8_SB(1, 0), b3, voffB);
            PG8_BAR; PG8_WAIT_L(0); PG8_MMA(0, 1, At, B1); PG8_BAR;
            PG8_LDA(At, 1, 1); PG8_STAGE(PG8_SA(1, 0), a3, voffA);
            PG8_BAR; PG8_WAIT_L(0); PG8_MMA(1, 0, At, B0); PG8_BAR; PG8_SCHED;
            PG8_STAGE(PG8_SB(1, 1), b3 + hstep, voffB);
            PG8_WAIT_V(6); PG8_BAR; PG8_MMA(1, 1, At, B1); PG8_BAR;
            }
        }
        if constexpr (ALIGN_EPI) { if (wr == 0) PG8_BAR; }
        if constexpr (!Epi::AFTER_DRAIN) { E(acc, cur, wr, wc, fr, fq); S.done(cur); }
        if (!has_next) break;
#pragma unroll
        for (int a = 0; a < 2; ++a)
#pragma unroll
            for (int b = 0; b < 2; ++b)
#pragma unroll
                for (int m = 0; m < 4; ++m)
#pragma unroll
                    for (int n = 0; n < 2; ++n) acc[a][b][m][n] = (f32x4){0.f, 0.f, 0.f, 0.f};
        cur = nxt; cA = nA; cB = nB; ++ui;
        if constexpr (ALIGN_EPI) { if (wr == 1) PG8_BAR; }
    }
    PG8_WAIT_V(0);
    if constexpr (!ALIGN_EPI) { if (wr == 0) PG8_BAR; }
    PG8_BAR;
    if constexpr (Epi::AFTER_DRAIN) { E.fused(acc, cur, wr, wc, fr, fq, lds, wid, lane); S.done(cur); }
#undef PG8_SA
#undef PG8_SB
#undef PG8_STAGE
#undef PG8_LDA
#undef PG8_LDB
#undef PG8_MMA
#undef PG8_WAIT_V
#undef PG8_WAIT_L
#undef PG8_BAR
#undef PG8_SCHED
}
}
namespace att {
typedef unsigned short bf16;
using bf16x8 = __attribute__((ext_vector_type(8))) short;
using s16x4  = __attribute__((ext_vector_type(4))) short;
using f32x16 = __attribute__((ext_vector_type(16))) float;
using u32x4  = __attribute__((ext_vector_type(4))) unsigned;
using u32x2  = __attribute__((ext_vector_type(2))) unsigned;
constexpr int D = 128, NW = 8, QBLK = 32, KVBLK = 64, SEQ = 8192, LDK = 1024;
constexpr size_t SHM_V = KVBLK * D * 2, SHM_K = KVBLK * D * 2, SHM_ATTN = 2 * SHM_V + 2 * SHM_K + NW * 64 * 4;
#define KSWZ(row, colB) ((row) * 256 + ((colB) ^ (((row) & 7) << 4)))
#define SBAR() __builtin_amdgcn_sched_barrier(0)
__device__ __forceinline__ int crow(int r, int hi) { return (r & 3) + 8 * (r >> 2) + 4 * hi; }
__device__ __forceinline__ constexpr int crow0(int r) { return (r & 3) + 8 * (r >> 2); }
typedef float cvt_f32x2_t __attribute__((ext_vector_type(2))); typedef __bf16 cvt_bf16x2_t __attribute__((ext_vector_type(2)));
__device__ __forceinline__ unsigned cvtpk(float lo, float hi) { cvt_f32x2_t v = {lo, hi}; cvt_bf16x2_t b = __builtin_convertvector(v, cvt_bf16x2_t); return __builtin_bit_cast(unsigned, b); }
__device__ __forceinline__ float bf2f(bf16 x) { return __uint_as_float((unsigned)x << 16); }
__device__ __forceinline__ bf16x8 ld8(const bf16* p) { return *reinterpret_cast<const bf16x8*>(p); }
#define ATT_PK4(P, BASE, OUT) do { unsigned a0 = cvtpk(P[BASE + 0], P[BASE + 1]), a1 = cvtpk(P[BASE + 2], P[BASE + 3]);   \
    unsigned b0 = cvtpk(P[BASE + 4], P[BASE + 5]), b1 = cvtpk(P[BASE + 6], P[BASE + 7]);                              \
    auto r0 = __builtin_amdgcn_permlane32_swap(a0, b0, false, false); auto r1 = __builtin_amdgcn_permlane32_swap(a1, b1, false, false); \
    u32x4 w = {r0[0], r1[0], r0[1], r1[1]}; OUT = *reinterpret_cast<bf16x8*>(&w); } while (0)
__device__ __forceinline__ void pack_p(const f32x16& p0, const f32x16& p1, bf16x8& pa0, bf16x8& pa1, bf16x8& pa2, bf16x8& pa3) {
  ATT_PK4(p0, 0, pa0); ATT_PK4(p0, 8, pa1); ATT_PK4(p1, 0, pa2); ATT_PK4(p1, 8, pa3);
}
__device__ __forceinline__ void qkt(f32x16& p0, f32x16& p1, const bf16* Ks, const bf16x8* qr, int r32, int hi) {
  p0 = f32x16{}; p1 = f32x16{};
#pragma unroll
  for (int d0 = 0; d0 < 8; ++d0) { int cb = (d0 * 16 + hi * 8) * 2;
    bf16x8 b0 = *reinterpret_cast<const bf16x8*>((const char*)Ks + KSWZ(r32, cb));
    bf16x8 b1 = *reinterpret_cast<const bf16x8*>((const char*)Ks + KSWZ(32 + r32, cb));
    p0 = __builtin_amdgcn_mfma_f32_32x32x16_bf16(b0, qr[d0], p0, 0, 0, 0);
    p1 = __builtin_amdgcn_mfma_f32_32x32x16_bf16(b1, qr[d0], p1, 0, 0, 0); }
}
__device__ __forceinline__ int v_st(int k, int c) { const int kk = (k & ~0xC) | ((k & 4) << 1) | ((k & 8) >> 1); return ((kk >> 3) * 4 + (c >> 5)) * 512 + ((kk & 7) * 32 + (c & 31)) * 2; }
__device__ __forceinline__ int v_rd_base(int lane) { return ((lane & 3) << 3) | (((lane >> 2) & 3) << 6) | (((lane >> 4) & 1) << 5) | (((lane >> 5) & 1) << 8); }
constexpr int v_rd_off(int d0, int ks, int half) { return d0 * 512 + ks * 4096 + half * 2048; }
template <int OFF> __device__ __forceinline__ s16x4 tr_read(int vb) {
  s16x4 r; asm volatile("ds_read_b64_tr_b16 %0, %1 offset:%2" : "=&v"(r) : "v"(vb), "i"(OFF) : "memory"); return r;
}
template <int D0> __device__ __forceinline__ void pv_one(f32x16& od, int vb, bf16x8 pa0, bf16x8 pa1, bf16x8 pa2, bf16x8 pa3) {
  const s16x4 l0 = tr_read<v_rd_off(D0, 0, 0)>(vb), h0 = tr_read<v_rd_off(D0, 0, 1)>(vb), l1 = tr_read<v_rd_off(D0, 1, 0)>(vb), h1 = tr_read<v_rd_off(D0, 1, 1)>(vb);
  const s16x4 l2 = tr_read<v_rd_off(D0, 2, 0)>(vb), h2 = tr_read<v_rd_off(D0, 2, 1)>(vb), l3 = tr_read<v_rd_off(D0, 3, 0)>(vb), h3 = tr_read<v_rd_off(D0, 3, 1)>(vb);
  asm volatile("s_waitcnt lgkmcnt(0)" ::: "memory"); SBAR();
#define ATT_PK(L, H) (bf16x8){L[0], L[1], L[2], L[3], H[0], H[1], H[2], H[3]}
  od = __builtin_amdgcn_mfma_f32_32x32x16_bf16(pa0, ATT_PK(l0, h0), od, 0, 0, 0);
  od = __builtin_amdgcn_mfma_f32_32x32x16_bf16(pa1, ATT_PK(l1, h1), od, 0, 0, 0);
  od = __builtin_amdgcn_mfma_f32_32x32x16_bf16(pa2, ATT_PK(l2, h2), od, 0, 0, 0);
  od = __builtin_amdgcn_mfma_f32_32x32x16_bf16(pa3, ATT_PK(l3, h3), od, 0, 0, 0);
#undef ATT_PK
}
__device__ __forceinline__ void pv_d0(f32x16* o, int vb, bf16x8 pa0, bf16x8 pa1, bf16x8 pa2, bf16x8 pa3) {
  pv_one<0>(o[0], vb, pa0, pa1, pa2, pa3); pv_one<1>(o[1], vb, pa0, pa1, pa2, pa3); pv_one<2>(o[2], vb, pa0, pa1, pa2, pa3); pv_one<3>(o[3], vb, pa0, pa1, pa2, pa3);
}
__device__ __forceinline__ void store_act(const f32x16* o, const float* rli, bf16* Ow, const bf16* Zw, int r32, int hi) {
  int lbase = 4 * hi * LDK + r32; asm volatile("" : "+v"(lbase));
#pragma unroll
  for (int r = 0; r < 16; ++r) { const int off = crow0(r) * LDK + lbase;
    const float z0 = bf2f(Zw[off]), z1 = bf2f(Zw[off + 32]), z2 = bf2f(Zw[off + 64]), z3 = bf2f(Zw[off + 96]);
    const float v0 = o[0][r] * rli[r] * z0, v1 = o[1][r] * rli[r] * z1, v2 = o[2][r] * rli[r] * z2, v3 = o[3][r] * rli[r] * z3;
    Ow[off] = (bf16)(cvtpk(v0, v0) & 0xffffu); Ow[off + 32] = (bf16)(cvtpk(v1, v1) & 0xffffu); Ow[off + 64] = (bf16)(cvtpk(v2, v2) & 0xffffu); Ow[off + 96] = (bf16)(cvtpk(v3, v3) & 0xffffu);
    if (r & 1) asm volatile("" ::: "memory"); }
}

__device__ __forceinline__ void sb_unit(int b, int h, int qb, bf16* Q, const bf16* __restrict__ K, const bf16* __restrict__ V, const bf16* __restrict__ Zs, char* lds, const int kwave) {
  const int lane = (int)__builtin_amdgcn_mbcnt_hi(~0u, __builtin_amdgcn_mbcnt_lo(~0u, 0u)), wid = kwave, tid = wid * 64 + lane, r32 = lane & 31, hi = lane >> 5;
  bf16* V_lds = (bf16*)lds; bf16* K_lds = (bf16*)(lds + SHM_V); int* flags = (int*)(lds + SHM_V + SHM_K);
  const long rowbase = (long)b * SEQ; const int t0 = qb * 256 + wid * 32, tq = t0 + r32;
  bf16x8 qr[8];
  { const bf16* Qw = Q + (rowbase + tq) * LDK + h * D + hi * 8;
#pragma unroll
    for (int d0 = 0; d0 < 8; ++d0) qr[d0] = ld8(Qw + d0 * 16); }
  const bf16* Kh = K + rowbase * LDK + h * D; const bf16* Vh = V + rowbase * LDK + h * D;
  const int sr = tid >> 4, sc = (tid & 15) * 8, vst0 = v_st(sr, sc), vst1 = v_st(32 + sr, sc);
  const int vb0 = (int)(uintptr_t)V_lds + v_rd_base(lane);
  f32x16 o[4] = {}; float carry = 0.f; bool done = false;
  const int NT = 4 * qb + 4, jw = 4 * qb + (wid >> 1);
  bf16x8 vs0, vs1, ks0, ks1;
#define SB_LOAD(k0) do { vs0 = ld8(&Vh[(long)((k0) + sr) * LDK + sc]); vs1 = ld8(&Vh[(long)((k0) + 32 + sr) * LDK + sc]); \
    ks0 = ld8(&Kh[(long)((k0) + sr) * LDK + sc]); ks1 = ld8(&Kh[(long)((k0) + 32 + sr) * LDK + sc]); } while (0)
  SB_LOAD((NT - 1) * KVBLK);
  for (int j = NT - 1; j >= 0; --j) {
    *(bf16x8*)((char*)V_lds + vst0) = vs0; *(bf16x8*)((char*)V_lds + vst1) = vs1;
    *(bf16x8*)((char*)K_lds + KSWZ(sr, sc * 2)) = ks0; *(bf16x8*)((char*)K_lds + KSWZ(32 + sr, sc * 2)) = ks1;
    __syncthreads();
    if (j > 0) SB_LOAD((j - 1) * KVBLK);
    if (j <= jw && !done) {
      f32x16 p0, p1; qkt(p0, p1, K_lds, qr, r32, hi);
      const bool diag = (j == jw); const int srel = tq - 64 * j - 4 * hi;
      const float fsel = hi ? 0.f : 1.f; float run = 0.f;
      { float L1[16];
#pragma unroll
        for (int r = 0; r < 16; ++r) { const float z = p1[r]; const float e = __builtin_amdgcn_exp2f(-__builtin_fabsf(z)); float L = -(__builtin_fmaxf(z, 0.f) + __builtin_amdgcn_logf(1.0f + e));
          if (diag && !(crow0(r) + 32 < srel)) L = 0.f; L1[r] = L; }
        float bb[4], pb[4], base1[4];
#pragma unroll
        for (int g = 0; g < 4; ++g) bb[g] = (L1[4 * g] + L1[4 * g + 1]) + (L1[4 * g + 2] + L1[4 * g + 3]);
#pragma unroll
        for (int g = 0; g < 4; ++g) pb[g] = __shfl_xor(bb[g], 32);
#pragma unroll
        for (int g = 3; g >= 0; --g) { base1[g] = run + fsel * pb[g]; run += bb[g] + pb[g]; }
#pragma unroll
        for (int g = 0; g < 4; ++g) { float s1 = carry + base1[g];
#pragma unroll
          for (int i = 3; i >= 0; --i) { const int r = 4 * g + i; s1 += L1[r]; float w1 = __builtin_amdgcn_exp2f(p1[r] + s1); if (diag && !(crow0(r) + 32 < srel)) w1 = 0.f; p1[r] = w1; } }
      }
      SBAR();
      { float L0[16];
#pragma unroll
        for (int r = 0; r < 16; ++r) { const float z = p0[r]; const float e = __builtin_amdgcn_exp2f(-__builtin_fabsf(z)); float L = -(__builtin_fmaxf(z, 0.f) + __builtin_amdgcn_logf(1.0f + e));
          if (diag && !(crow0(r) < srel)) L = 0.f; L0[r] = L; }
        float a[4], pa[4], base0[4];
#pragma unroll
        for (int g = 0; g < 4; ++g) a[g] = (L0[4 * g] + L0[4 * g + 1]) + (L0[4 * g + 2] + L0[4 * g + 3]);
#pragma unroll
        for (int g = 0; g < 4; ++g) pa[g] = __shfl_xor(a[g], 32);
#pragma unroll
        for (int g = 3; g >= 0; --g) { base0[g] = run + fsel * pa[g]; run += a[g] + pa[g]; }
#pragma unroll
        for (int g = 0; g < 4; ++g) { float s0 = carry + base0[g];
#pragma unroll
          for (int i = 3; i >= 0; --i) { const int r = 4 * g + i; s0 += L0[r]; float w0 = __builtin_amdgcn_exp2f(p0[r] + s0); if (diag && !(crow0(r) < srel)) w0 = 0.f; p0[r] = w0; } }
      }
      carry += run;
      bf16x8 pa0, pa1, pa2, pa3; pack_p(p0, p1, pa0, pa1, pa2, pa3);
      SBAR(); pv_d0(o, vb0, pa0, pa1, pa2, pa3);
      done = __all(carry < -160.f);
    }
    if (lane == 0) flags[wid] = done ? 1 : 0;
    __syncthreads();
    const int alld = flags[0] & flags[1] & flags[2] & flags[3] & flags[4] & flags[5] & flags[6] & flags[7];
    if (alld) break;
  }
#undef SB_LOAD
  float rli[16];
#pragma unroll
  for (int r = 0; r < 16; ++r) rli[r] = 1.0f;
  store_act(o, rli, Q + (rowbase + t0) * LDK + h * D, Zs + (rowbase + t0) * LDK + h * D, r32, hi);
  __syncthreads();
}

constexpr float THR2 = 11.5f;
__device__ __forceinline__ void sa_partial(f32x16& p0, f32x16& p1, float& m_reg, float& mn, float& alpha, u32x2 mw, float dbase, float nslope2, int hi) {
  const unsigned mx = mw.x >> (4 * hi), my = mw.y >> (4 * hi);
#pragma unroll
  for (int r = 0; r < 16; ++r) {
    const float d0 = dbase - (float)crow0(r), d1 = dbase - (float)(crow0(r) + 32);
    float x0 = __builtin_fmaf(__builtin_fabsf(d0), nslope2, p0[r]), x1 = __builtin_fmaf(__builtin_fabsf(d1), nslope2, p1[r]);
    const int s0 = ((int)(mx << (31 - crow0(r)))) >> 31, s1 = ((int)(my << (31 - crow0(r)))) >> 31;
    p0[r] = __int_as_float((__float_as_int(x0) & s0) | (~s0 & (int)0xff800000));
    p1[r] = __int_as_float((__float_as_int(x1) & s1) | (~s1 & (int)0xff800000));
  }
  float pmax = p0[0];
#pragma unroll
  for (int r = 1; r < 16; ++r) pmax = fmaxf(pmax, p0[r]);
#pragma unroll
  for (int r = 0; r < 16; ++r) pmax = fmaxf(pmax, p1[r]);
  { auto rr = __builtin_amdgcn_permlane32_swap(__float_as_uint(pmax), __float_as_uint(pmax), false, false);
    pmax = fmaxf(__uint_as_float(rr[0]), __uint_as_float(rr[1])); }
  if (__builtin_expect(__all(pmax - m_reg <= THR2), 1)) { mn = m_reg; alpha = 1.f; }
  else { mn = fmaxf(m_reg, pmax); alpha = __builtin_amdgcn_exp2f(m_reg - mn); m_reg = mn; }
#pragma unroll
  for (int r = 0; r < 16; ++r) { p0[r] = p0[r] - mn; p1[r] = p1[r] - mn; }
#pragma unroll
  for (int r = 0; r < 16; ++r) p0[r] = __builtin_amdgcn_exp2f(p0[r]);
}
__device__ __forceinline__ void sa_finish(f32x16& p0, f32x16& p1, float alpha, float& l_reg, bf16x8& pa0, bf16x8& pa1, bf16x8& pa2, bf16x8& pa3) {
#pragma unroll
  for (int r = 0; r < 16; ++r) p1[r] = __builtin_amdgcn_exp2f(p1[r]);
  float ps = 0;
#pragma unroll
  for (int r = 0; r < 16; ++r) ps += p0[r];
#pragma unroll
  for (int r = 0; r < 16; ++r) ps += p1[r];
  { auto rr = __builtin_amdgcn_permlane32_swap(__float_as_uint(ps), __float_as_uint(ps), false, false);
    ps = __uint_as_float(rr[0]) + __uint_as_float(rr[1]); }
  l_reg = l_reg * alpha + ps;
  pack_p(p0, p1, pa0, pa1, pa2, pa3);
}
__device__ __forceinline__ void sa_unit(int b, int h, int qb, bf16* Q, const bf16* __restrict__ K, const bf16* __restrict__ V, const bf16* __restrict__ Zs,
                                        const u32x2* __restrict__ maskp, char* lds, const int kwave) {
  const int lane = (int)__builtin_amdgcn_mbcnt_hi(~0u, __builtin_amdgcn_mbcnt_lo(~0u, 0u)), wid = kwave, tid = wid * 64 + lane, r32 = lane & 31, hi = lane >> 5;
  bf16* V_lds = (bf16*)lds; bf16* K_lds = (bf16*)(lds + 2 * SHM_V);
  float* ws = (float*)(lds + 2 * SHM_V + 2 * SHM_K) + wid * 64; float* li_l = ws; float* al_l = ws + 32;
  const long rowbase = (long)b * SEQ; const int t0 = qb * 256 + wid * 32, tq = t0 + r32;
  float m_reg = -1e30f, l_reg = 0; f32x16 o[4] = {}; bf16x8 qr[8];
  { const bf16* Qw = Q + (rowbase + tq) * LDK + h * D + hi * 8;
#pragma unroll
    for (int d0 = 0; d0 < 8; ++d0) qr[d0] = ld8(Qw + d0 * 16); }
  const bf16* Kh = K + rowbase * LDK + h * D; const bf16* Vh = V + rowbase * LDK + h * D;
  const u32x2* mrow = maskp + (rowbase + tq) * 128;
  const float nslope2 = -1.4426950408889634f * __builtin_amdgcn_exp2f(-(float)(h + 1));
  const int sr = tid >> 4, sc = (tid & 15) * 8, vst0 = v_st(sr, sc), vst1 = v_st(32 + sr, sc);
  const int vb0 = (int)(uintptr_t)V_lds + v_rd_base(lane);
  struct { bf16x8 vs0, vs1, ks0, ks1; } sr_[1];
  const int NT = 4 * qb + 4;
#define KOF(i) ((NT - 1 - (i)) * KVBLK)
#define DBASE(i) ((float)(tq - KOF(i) - 4 * hi))
#define SLOAD(i, k0) do { sr_[i].vs0 = ld8(&Vh[(long)((k0) + sr) * LDK + sc]); sr_[i].vs1 = ld8(&Vh[(long)((k0) + 32 + sr) * LDK + sc]); \
    sr_[i].ks0 = ld8(&Kh[(long)((k0) + sr) * LDK + sc]); sr_[i].ks1 = ld8(&Kh[(long)((k0) + 32 + sr) * LDK + sc]); } while (0)
#define SWRITE(bf, i) do { *(bf16x8*)((char*)V_lds + (bf) * SHM_V + vst0) = sr_[i].vs0;          \
    *(bf16x8*)((char*)V_lds + (bf) * SHM_V + vst1) = sr_[i].vs1; int kc = sc * 2;               \
    *(bf16x8*)((char*)K_lds + (bf) * SHM_K + KSWZ(sr, kc)) = sr_[i].ks0;                       \
    *(bf16x8*)((char*)K_lds + (bf) * SHM_K + KSWZ(32 + sr, kc)) = sr_[i].ks1; } while (0)
#define SWAIT() asm volatile("s_waitcnt vmcnt(0)" ::: "memory")
#define RESC(a) do { if (__any((a) < 1.f)) { if (hi == 0) al_l[r32] = (a); asm volatile("s_waitcnt lgkmcnt(0)" ::: "memory"); \
    _Pragma("unroll") for (int d = 0; d < 4; ++d) _Pragma("unroll") for (int r = 0; r < 16; ++r) o[d][r] *= al_l[crow(r, hi)]; } } while (0)
  f32x16 pA0, pA1, pB0, pB1; float mnA, mnB, alA, alB; bf16x8 pa0, pa1, pa2, pa3;
  constexpr int SE = 0, SO = 0;
  u32x2 mwA = mrow[NT - 1], mwB;
  SLOAD(SE, KOF(0)); asm volatile("s_waitcnt vmcnt(0)" ::: "memory"); SWRITE(0, SE); __syncthreads();
  qkt(pA0, pA1, K_lds, qr, r32, hi); sa_partial(pA0, pA1, m_reg, mnA, alA, mwA, DBASE(0), nslope2, hi);
  SLOAD(SO, KOF(1));
  SWAIT(); SWRITE(1, SO); __syncthreads();
  for (int j = 1; j + 1 < NT; j += 2) {
    mwB = mrow[NT - 1 - j];
    SBAR(); qkt(pB0, pB1, (bf16*)((char*)K_lds + SHM_K), qr, r32, hi);
    sa_finish(pA0, pA1, alA, l_reg, pa0, pa1, pa2, pa3); SBAR();
    SLOAD(SE, KOF(j + 1)); SBAR();
    pv_d0(o, vb0, pa0, pa1, pa2, pa3); sa_partial(pB0, pB1, m_reg, mnB, alB, mwB, DBASE(j), nslope2, hi);
    __syncthreads(); SWAIT(); SWRITE(0, SE);
    RESC(alB); __syncthreads();
    mwA = mrow[NT - 2 - j];
    SBAR(); qkt(pA0, pA1, K_lds, qr, r32, hi);
    sa_finish(pB0, pB1, alB, l_reg, pa0, pa1, pa2, pa3); SBAR();
    SLOAD(SO, KOF(j + 2)); SBAR();
    pv_d0(o, vb0 + (int)SHM_V, pa0, pa1, pa2, pa3); sa_partial(pA0, pA1, m_reg, mnA, alA, mwA, DBASE(j + 1), nslope2, hi);
    __syncthreads(); SWAIT(); SWRITE(1, SO);
    RESC(alA); __syncthreads();
  }
  mwB = mrow[0];
  SBAR(); qkt(pB0, pB1, (bf16*)((char*)K_lds + SHM_K), qr, r32, hi);
  sa_finish(pA0, pA1, alA, l_reg, pa0, pa1, pa2, pa3); SBAR();
  pv_d0(o, vb0, pa0, pa1, pa2, pa3); sa_partial(pB0, pB1, m_reg, mnB, alB, mwB, DBASE(NT - 1), nslope2, hi);
  __syncthreads(); RESC(alB);
  sa_finish(pB0, pB1, alB, l_reg, pa0, pa1, pa2, pa3); SBAR();
  pv_d0(o, vb0 + (int)SHM_V, pa0, pa1, pa2, pa3);
  if (hi == 0) li_l[r32] = l_reg; asm volatile("s_waitcnt lgkmcnt(0)" ::: "memory");
  float rli[16];
#pragma unroll
  for (int r = 0; r < 16; ++r) rli[r] = __builtin_amdgcn_rcpf(li_l[crow(r, hi)]);
  store_act(o, rli, Q + (rowbase + t0) * LDK + h * D, Zs + (rowbase + t0) * LDK + h * D, r32, hi);
  __syncthreads();
#undef KOF
#undef DBASE
#undef SLOAD
#undef SWRITE
#undef SWAIT
#undef RESC
}
#undef KSWZ
#undef SBAR
}

namespace idx {
typedef unsigned short bf16;
using bf16x8 = __attribute__((ext_vector_type(8))) short;
using f32x4  = __attribute__((ext_vector_type(4))) float;
using u32x4  = __attribute__((ext_vector_type(4))) unsigned;
using u32x2  = __attribute__((ext_vector_type(2))) unsigned;
constexpr int SEQ = 8192;
__device__ __forceinline__ float bf2f(short x) { return __uint_as_float(((unsigned)(unsigned short)x) << 16); }
typedef float cvt_f32x2_t __attribute__((ext_vector_type(2))); typedef __bf16 cvt_bf16x2_t __attribute__((ext_vector_type(2)));
__device__ __forceinline__ unsigned cvtpk(float lo, float hi) { cvt_f32x2_t v = {lo, hi}; cvt_bf16x2_t b = __builtin_convertvector(v, cvt_bf16x2_t); return __builtin_bit_cast(unsigned, b); }
__device__ __forceinline__ unsigned monokey(float s) { const unsigned u = __float_as_uint(s); return u ^ ((unsigned)((int)u >> 31) | 0x80000000u); }

#define IDX_HEAD(sc, ka0, ka1, qa, qb, w_) do { \
      f32x4 x_ = __builtin_amdgcn_mfma_f32_16x16x32_bf16(ka0, qa, (f32x4){0.f, 0.f, 0.f, 0.f}, 0, 0, 0); x_ = __builtin_amdgcn_mfma_f32_16x16x32_bf16(ka1, qb, x_, 0, 0, 0); \
      sc[0] = __builtin_fmaf(__builtin_fabsf(x_[0]), w_, sc[0]); sc[1] = __builtin_fmaf(__builtin_fabsf(x_[1]), w_, sc[1]); \
      sc[2] = __builtin_fmaf(__builtin_fabsf(x_[2]), w_, sc[2]); sc[3] = __builtin_fmaf(__builtin_fabsf(x_[3]), w_, sc[3]); } while (0)
#define IDX_SCORE(sc, ka0, ka1) do { \
    sc = __builtin_amdgcn_mfma_f32_16x16x32_bf16(ka0, qlin0, (f32x4){0.f, 0.f, 0.f, 0.f}, 0, 0, 0); sc = __builtin_amdgcn_mfma_f32_16x16x32_bf16(ka1, qlin1, sc, 0, 0, 0); \
    _Pragma("unroll") for (int h_ = 0; h_ < 8; ++h_) { IDX_HEAD(sc, ka0, ka1, q[h_][0], q[h_][1], wh[h_]); __builtin_amdgcn_sched_barrier(0); } \
    _Pragma("unroll") for (int h_ = 0; h_ < 8; ++h_) { const bf16x8 qa_ = qlds[(h_ * 2 + 0) * 64], qb_ = qlds[(h_ * 2 + 1) * 64]; \
      IDX_HEAD(sc, ka0, ka1, qa_, qb_, wh[8 + h_]); __builtin_amdgcn_sched_barrier(0); } } while (0)

constexpr int HIST_OFF = 0, CAND_OFF = 0  , CAND_CAP = 250, QLDS_OFF = 65536  , THR_OFF = QLDS_OFF + 32768, CCNT_OFF = THR_OFF + 256, RED_OFF = CCNT_OFF + 128;
__device__ __forceinline__ int ord_of(float s, unsigned ulo) {
  const unsigned u = __float_as_uint(s) & 0x7fffffffu; int key = ((int)(u - ulo)) >> 18; key = key < 0 ? 0 : (key > 511 ? 511 : key);
  return (__float_as_int(s) >= 0) ? 511 - key : 512 + key;
}
__device__ __forceinline__ void idx_unit(int b, int c, int hf, const bf16* __restrict__ Qidx, const bf16* __restrict__ kidx, const float* __restrict__ widx, u32x2* maskp, char* lds, const int kwave) {
  const int lane = (int)__builtin_amdgcn_mbcnt_hi(~0u, __builtin_amdgcn_mbcnt_lo(~0u, 0u)), wid = kwave, tid = wid * 64 + lane, g = wid & 1, kq = wid >> 1, qi = lane & 15, kg = lane >> 4;
  const int row = 16 * g + qi; const long rowu = (long)b * SEQ + 64 * c + 32 * hf;
  const bf16* Quni = Qidx + rowu * 1024; const float* Wuni = widx + rowu * 16;
  const int NT = c + 1;
  unsigned* hist = (unsigned*)(lds + HIST_OFF); u32x2* cand = (u32x2*)(lds + CAND_OFF); u32x2* thr = (u32x2*)(lds + THR_OFF); unsigned* ccnt = (unsigned*)(lds + CCNT_OFF); float* red = (float*)(lds + RED_OFF);
  const bf16* kuni = kidx + (long)b * SEQ * 64; const int koff = qi * 64 + kg * 8;
  u32x2* muni = maskp + rowu * 128;
  unsigned ulo = 0u; int ordstar = 4096;
  if (NT > 4) {
    float qn = 0.f;
#pragma unroll 1
    for (int h = 0; h < 16; ++h) { const bf16x8 a = *reinterpret_cast<const bf16x8*>(Quni + (unsigned)(row * 1024 + h * 64 + kg * 8)), bq = *reinterpret_cast<const bf16x8*>(Quni + (unsigned)(row * 1024 + h * 64 + 32 + kg * 8)); float ss = 0.f;
#pragma unroll
      for (int e = 0; e < 8; ++e) { const float a0 = bf2f(a[e]), a1 = bf2f(bq[e]); ss = __builtin_fmaf(a0, a0, ss); ss = __builtin_fmaf(a1, a1, ss); }
      ss += __shfl_xor(ss, 16); ss += __shfl_xor(ss, 32); qn = __builtin_fmaf(__builtin_fabsf(0.5f * Wuni[(unsigned)(row * 16 + h)]), __builtin_sqrtf(ss), qn); }
    float km2 = 0.f;
    for (int s = tid; s < 64 * NT; s += 512) { const bf16x8* kr = reinterpret_cast<const bf16x8*>(kidx + ((long)b * SEQ + s) * 64); float ss = 0.f;
#pragma unroll
      for (int v = 0; v < 8; ++v) { const bf16x8 x = kr[v];
#pragma unroll
        for (int e = 0; e < 8; ++e) { const float a = bf2f(x[e]); ss = __builtin_fmaf(a, a, ss); } }
      km2 = __builtin_fmaxf(km2, ss); }
#pragma unroll
    for (int o = 1; o < 64; o <<= 1) km2 = __builtin_fmaxf(km2, __shfl_xor(km2, o));
    if (lane == 0) red[wid] = km2;
    for (int i = tid; i < 65536 / 16; i += 512) reinterpret_cast<u32x4*>(hist)[i] = (u32x4){0u, 0u, 0u, 0u};
    if (tid < 32) ccnt[tid] = 0u;
    __syncthreads();
    float kmx = red[0];
#pragma unroll
    for (int i = 1; i < 8; ++i) kmx = __builtin_fmaxf(kmx, red[i]);
    const float B = 2.04f * qn * __builtin_sqrtf(kmx) + 1e-30f;
    ulo = __float_as_uint(B * 1.52587890625e-05f);
  }
#pragma unroll 1
  for (int pass = (NT > 4) ? 0 : 1; pass < 2; ++pass) {
    const bool emit = (pass == 1); unsigned lo = 0u, hiw = 0u;
    bf16x8 q[8][2]; float wh[16]; bf16x8 qlin0, qlin1;
    unsigned long long qpi = (unsigned long long)(Quni + row * 1024 + kg * 8), wpi = (unsigned long long)(Wuni + row * 16); asm volatile("" : "+v"(qpi), "+v"(wpi));
    const __attribute__((address_space(1))) bf16* qrow = (const __attribute__((address_space(1))) bf16*)qpi; const __attribute__((address_space(1))) float* wrow = (const __attribute__((address_space(1))) float*)wpi;
    const bf16x8* qlds = reinterpret_cast<const bf16x8*>(lds + QLDS_OFF) + g * 1024 + lane;
    { float l0[8], l1[8];
#pragma unroll
      for (int e = 0; e < 8; ++e) { l0[e] = 0.f; l1[e] = 0.f; }
#pragma unroll
      for (int h = 0; h < 8; ++h) {
        const bf16x8 a = *reinterpret_cast<const __attribute__((address_space(1))) bf16x8*>(qrow + h * 64), bq = *reinterpret_cast<const __attribute__((address_space(1))) bf16x8*>(qrow + h * 64 + 32);
        wh[h] = 0.5f * wrow[h]; q[h][0] = a; q[h][1] = bq;
#pragma unroll
        for (int e = 0; e < 8; ++e) { l0[e] = __builtin_fmaf(wh[h], bf2f(a[e]), l0[e]); l1[e] = __builtin_fmaf(wh[h], bf2f(bq[e]), l1[e]); }
        asm volatile("" ::: "memory"); }
      bf16x8* qw = reinterpret_cast<bf16x8*>(lds + QLDS_OFF) + g * 1024 + lane;
#pragma unroll 1
      for (int h = 8; h < 16; ++h) {
        const bf16x8 a = *reinterpret_cast<const __attribute__((address_space(1))) bf16x8*>(qrow + h * 64), bq = *reinterpret_cast<const __attribute__((address_space(1))) bf16x8*>(qrow + h * 64 + 32);
        const float w = 0.5f * wrow[h];
        if (kq == 0) { qw[((h - 8) * 2 + 0) * 64] = a; qw[((h - 8) * 2 + 1) * 64] = bq; }
#pragma unroll
        for (int e = 0; e < 8; ++e) { l0[e] = __builtin_fmaf(w, bf2f(a[e]), l0[e]); l1[e] = __builtin_fmaf(w, bf2f(bq[e]), l1[e]); } }
#pragma unroll
      for (int h = 8; h < 16; ++h) wh[h] = 0.5f * wrow[h];
      u32x4 w0 = {cvtpk(l0[0], l0[1]), cvtpk(l0[2], l0[3]), cvtpk(l0[4], l0[5]), cvtpk(l0[6], l0[7])};
      u32x4 w1 = {cvtpk(l1[0], l1[1]), cvtpk(l1[2], l1[3]), cvtpk(l1[4], l1[5]), cvtpk(l1[6], l1[7])};
      qlin0 = *reinterpret_cast<bf16x8*>(&w0); qlin1 = *reinterpret_cast<bf16x8*>(&w1); }
    __syncthreads();
#pragma unroll 1
    for (int js = 4 * kq; js < 4 * NT; js += (js & 3) == 3 ? 13 : 1) {
      asm volatile("" : "+v"(qlds));
      const bf16* kp = kuni + (unsigned)(1024 * js + koff);
      const bf16x8 ka0 = *reinterpret_cast<const bf16x8*>(kp), ka1 = *reinterpret_cast<const bf16x8*>(kp + 32);
      f32x4 sc; IDX_SCORE(sc, ka0, ka1);
      if (!emit) {
#pragma unroll
        for (int r = 0; r < 4; ++r) { const int od = ord_of(sc[r], ulo); atomicAdd(hist + row * 512 + (od >> 1), (od & 1) ? 0x10000u : 1u); }
      } else {
        unsigned bits = 0u;
#pragma unroll
        for (int r = 0; r < 4; ++r) { const int od = ord_of(sc[r], ulo); bits |= (od < ordstar) ? (1u << r) : 0u;
          if (od == ordstar) { const unsigned pos = atomicAdd(ccnt + row, 1u); if (pos < (unsigned)CAND_CAP) cand[row * CAND_CAP + pos] = (u32x2){__float_as_uint(sc[r]), (unsigned)(16 * js + 4 * kg + r)}; } }
        const int sub = js & 3; bits <<= (4 * kg + 16 * (sub & 1));
        if (sub < 2) lo |= bits; else hiw |= bits;
        if (sub == 3) {
          lo |= __shfl_xor(lo, 16); lo |= __shfl_xor(lo, 32); hiw |= __shfl_xor(hiw, 16); hiw |= __shfl_xor(hiw, 32);
          if (kg == 0) muni[row * 128 + (js >> 2)] = (u32x2){lo, hiw};
          lo = 0u; hiw = 0u; }
      }
    }
    if (!emit) {
      __syncthreads();
#pragma unroll 1
      for (int rr = 0; rr < 4; ++rr) { const int srow = 4 * wid + rr;
        const u32x4 h0 = *reinterpret_cast<const u32x4*>(hist + srow * 512 + 8 * lane), h1 = *reinterpret_cast<const u32x4*>(hist + srow * 512 + 8 * lane + 4);
        unsigned cb[16] = {h0.x & 0xffffu, h0.x >> 16, h0.y & 0xffffu, h0.y >> 16, h0.z & 0xffffu, h0.z >> 16, h0.w & 0xffffu, h0.w >> 16,
                           h1.x & 0xffffu, h1.x >> 16, h1.y & 0xffffu, h1.y >> 16, h1.z & 0xffffu, h1.z >> 16, h1.w & 0xffffu, h1.w >> 16};
        unsigned lsum = 0u;
#pragma unroll
        for (int k = 0; k < 16; ++k) lsum += cb[k];
        unsigned incl = lsum;
#pragma unroll
        for (int o = 1; o < 64; o <<= 1) { const unsigned tt = __shfl_up(incl, o); if (lane >= o) incl += tt; }
        const unsigned long long bal = __ballot(incl >= 256u);
        const int L = bal ? (int)__builtin_ctzll(bal) : 63;
        if (lane == L) { unsigned cum = incl - lsum; int os = 16 * lane + 15; unsigned need = 0u; bool found = false;
#pragma unroll
          for (int k = 0; k < 16; ++k) { if (!found && cum + cb[k] >= 256u) { os = 16 * lane + k; need = 256u - cum; found = true; } cum += cb[k]; }
          thr[srow] = (u32x2){(unsigned)os, need}; }
      }
      __syncthreads();
      ordstar = (int)thr[row].x;
    }
  }
  if (kq == 0 && kg == 0) for (int j = NT; j <= (c | 3); ++j) muni[row * 128 + j] = (u32x2){0u, 0u};
  if (NT > 4) {
    asm volatile("s_waitcnt vmcnt(0)" ::: "memory");
    __syncthreads();
#pragma unroll 1
    for (int rr = 0; rr < 4; ++rr) { const int srow = 4 * wid + rr; const int n = (int)(ccnt[srow] < (unsigned)CAND_CAP ? ccnt[srow] : (unsigned)CAND_CAP); const unsigned need = thr[srow].y;
      for (int i = lane; i < n; i += 64) { const u32x2 me = cand[srow * CAND_CAP + i]; const float ms = __uint_as_float(me.x); unsigned rank = 0u;
        for (int j = 0; j < n; ++j) { const u32x2 ot = cand[srow * CAND_CAP + j]; const float os = __uint_as_float(ot.x); rank += (os > ms || (os == ms && ot.y < me.y)) ? 1u : 0u; }
        if (rank < need) atomicOr(reinterpret_cast<unsigned*>(muni + srow * 128 + (me.y >> 6)) + ((me.y >> 5) & 1), 1u << (me.y & 31)); }
    }
  }
}
#undef IDX_SCORE
}

constexpr int NWAVES = 8;
#ifndef MK_N_LAUNCHES
#define MK_N_LAUNCHES 1
#endif
constexpr int N_PHASES = 7;
constexpr int N_LAUNCHES = MK_N_LAUNCHES;
static_assert(N_LAUNCHES == 1 || N_LAUNCHES == N_PHASES, "MK_N_LAUNCHES is 1 or 7");

constexpr int BATCH = 2, SEQ = 8192, DMODEL = 2048, M = BATCH * SEQ, BW = 1024  , NPACK = 13568  , NIN = 13392;
constexpr float RMS_EPS = 1e-6f;
constexpr float QSCALE = 0.08838834764831845f * 1.4426950408889634f;

constexpr size_t MiB = 1u << 20;
constexpr size_t WS_CTL = 0, CTL_ZERO_BYTES = 1 * MiB;
constexpr size_t WS_KIDX = 1 * MiB;
constexpr size_t WS_WIDX = 3 * MiB;
constexpr size_t WS_PSS  = 4 * MiB;
constexpr size_t WS_WSB  = 6 * MiB, WS_WSA = 10 * MiB, WS_WOUT = 14 * MiB;
constexpr size_t WS_MASK = 22 * MiB;
constexpr size_t WS_P9   = 38 * MiB;
constexpr size_t P9_STRIDE = (size_t)M * 1024 * 2;
constexpr size_t WS_G    = WS_P9 + 9 * P9_STRIDE;
constexpr size_t WS_END  = WS_G + (size_t)M * 4096 * 2;
constexpr size_t WS_T1   = WS_P9 + 1 * P9_STRIDE;
constexpr size_t WS_MIX  = WS_P9 + 5 * P9_STRIDE;
constexpr size_t OUT_WIN = 0, OUT_XN = 56 * MiB;
static_assert(OUT_XN >= (size_t)NPACK * DMODEL * 2 && OUT_XN + (size_t)M * DMODEL * 2 <= (size_t)M * DMODEL * 4, "d_out scratch map");
constexpr int CW_TMO = 0, CW_CODE = 1, CW_BAR = 4096;

constexpr int RING_OFF = 0, RING_BYTES = 131072;
constexpr int LDSCTL_OFF = RING_BYTES, MISC_OFF = LDSCTL_OFF + 320;
constexpr int LDS_BYTES = 147456;
static_assert(MISC_OFF + 128 <= LDS_BYTES, "LDS map");

#define GAS __attribute__((address_space(1)))
#define LAS __attribute__((address_space(3)))
typedef unsigned short bf16;
typedef unsigned v4u __attribute__((ext_vector_type(4)));
typedef float f32x4 __attribute__((ext_vector_type(4)));
typedef short bf16x8 __attribute__((ext_vector_type(8)));
typedef GAS unsigned gu32;
typedef GAS unsigned long long gu64;
#define RLX_AGENT __ATOMIC_RELAXED, __HIP_MEMORY_SCOPE_AGENT
#define LDS_WAIT() asm volatile("s_waitcnt lgkmcnt(0)" ::: "memory")
#define VM_WAIT() asm volatile("s_waitcnt vmcnt(0)" ::: "memory")
__device__ __forceinline__ unsigned long long rt() { return __builtin_amdgcn_s_memrealtime(); }
__device__ __forceinline__ unsigned f2bf(float f) { unsigned u = __builtin_bit_cast(unsigned, f); return (u + 0x7fffu + ((u >> 16) & 1u)) >> 16; }
__device__ __forceinline__ unsigned pk2(float lo, float hi) { return f2bf(lo) | (f2bf(hi) << 16); }
#define XB_TMO      128
#define XB_XCNT(j)  (256  + 64 * (j))
#define XB_XSUB(j)  (1280 + 64 * (j))
#define XB_XGEN(j)  (2304 + 64 * (j))
#define XB_TOP      3328
#define XB_TOPGEN   3392
#define XCD_BAR_WORDS 3456
#define XB_SPIN_CAP (1u << 22)

__device__ __forceinline__ unsigned xb_ld(unsigned* p)              { return __hip_atomic_load(p, __ATOMIC_RELAXED, __HIP_MEMORY_SCOPE_AGENT); }
__device__ __forceinline__ unsigned xb_add(unsigned* p, unsigned v) { return __hip_atomic_fetch_add(p, v, __ATOMIC_RELAXED, __HIP_MEMORY_SCOPE_AGENT); }
__device__ __forceinline__ unsigned xb_xcc_id() { return (unsigned)__builtin_amdgcn_s_getreg((3 << 11) | 20) & 0xFu; }
#define XB_SPIN(cond, bar) do { unsigned _sp = 0; while (cond) { __builtin_amdgcn_s_sleep(1); \
    if ((++_sp & 255u) == 0u) { if (xb_ld(&(bar)[XB_TMO])) break; if (_sp > XB_SPIN_CAP) { atomicAdd(&(bar)[XB_TMO], 1u); break; } } } } while (0)

struct XcdBarrier {
    unsigned* bar; unsigned x;
    volatile LAS unsigned* st;
};

__device__ __forceinline__ XcdBarrier xcd_barrier_post(unsigned* bar, volatile LAS unsigned* st, const bool t0) {
    XcdBarrier b; b.bar = bar; b.x = xb_xcc_id(); b.st = st;
    if (t0) (void)xb_add(&bar[XB_XCNT(b.x)], 1u);
    return b;
}
__device__ __forceinline__ void xcd_barrier_complete(unsigned* bar, unsigned x, unsigned& nloc, unsigned& nx) {
    const unsigned G = gridDim.x * gridDim.y * gridDim.z;
    unsigned sum, cnt, mine, sp = 0u;
    for (;;) {
        sum = 0u; cnt = 0u; mine = 0u;
#pragma unroll
        for (unsigned j = 0; j < 16; ++j) { const unsigned c = xb_ld(&bar[XB_XCNT(j)]); sum += c; cnt += (c > 0u) ? 1u : 0u; mine = (j == x) ? c : mine; }
        if (sum == G) break;
        __builtin_amdgcn_s_sleep(1);
        if ((++sp & 255u) == 0u) { if (xb_ld(&bar[XB_TMO])) break; if (sp > XB_SPIN_CAP) { atomicAdd(&bar[XB_TMO], 1u); break; } }
    }
    nloc = mine > 0u ? mine : 1u; nx = cnt > 0u ? cnt : 1u;
}

__device__ __forceinline__ void xcd_barrier(const XcdBarrier& b, const bool t0) {
    asm volatile("s_waitcnt vmcnt(0)" ::: "memory");
    __syncthreads();
    if (t0) {
        unsigned* bar = b.bar;
        __builtin_amdgcn_s_waitcnt(0);
        unsigned nloc = b.st[0], nx = b.st[1];
        if (nloc == 0u) { xcd_barrier_complete(bar, b.x, nloc, nx); b.st[0] = nloc; b.st[1] = nx; }
        const unsigned old = xb_add(&bar[XB_XSUB(b.x)], 1u);
        const unsigned gen = old / nloc;
        if (old + 1u == (gen + 1u) * nloc) {
            __builtin_amdgcn_fence(__ATOMIC_RELEASE, "agent");
            asm volatile("s_waitcnt vmcnt(0)" ::: "memory");
            const unsigned og = xb_add(&bar[XB_TOP], 1u);
            const unsigned tg = og / nx;
            if (og + 1u == (tg + 1u) * nx) xb_add(&bar[XB_TOPGEN], 1u);
            else XB_SPIN(xb_ld(&bar[XB_TOPGEN]) == tg, bar);
            __builtin_amdgcn_fence(__ATOMIC_ACQUIRE, "agent");
            xb_add(&bar[XB_XGEN(b.x)], 1u);
            asm volatile("s_waitcnt vmcnt(0)" ::: "memory");
        } else {
            XB_SPIN(xb_ld(&bar[XB_XGEN(b.x)]) == gen, bar);
            __builtin_amdgcn_fence(__ATOMIC_ACQUIRE, "agent");
            asm volatile("s_waitcnt vmcnt(0)" ::: "memory");
        }
    }
    __syncthreads();
}
struct Frame {
    LAS unsigned char* lds;
    volatile LAS unsigned* MISC;
    gu32* ctl;
    int wave;
    int vcu, G;
    const float *x, *gain, *w_in, *w_sb, *w_sa, *w_out, *fgain; float* out;
    unsigned char *ws, *outb;
};
__device__ __forceinline__ float wave_sum(float v) {
#pragma unroll
    for (int o = 1; o < 64; o <<= 1) v += __shfl_xor(v, o);
    return v;
}
template <class CMap>
__device__ __forceinline__ void p0_transpose_item(const float* W, int ldw, int K, bf16* WT, const float* rowgain, const CMap& cm, LAS float* scr, int kb, int nb, int lane) {
    const int k0 = 64 * kb, n0 = 32 * nb, n = n0 + (lane & 31); float sc; const int cs = cm(n, sc);
#pragma unroll 8
    for (int i = 0; i < 32; ++i) { const int kk = 2 * i + (lane >> 5); float v = 0.f;
        if (cs >= 0) { v = W[(size_t)(k0 + kk) * ldw + cs] * sc; if (rowgain) v *= rowgain[k0 + kk]; }
        scr[kk * 33 + (lane & 31)] = v; }
    LDS_WAIT(); asm volatile("" ::: "memory");
    const int c = lane & 7;
#pragma unroll
    for (int j = 0; j < 4; ++j) { const int nn = (lane >> 3) + 8 * j; const LAS float* s = scr + (8 * c) * 33 + nn;
        v4u o; o.x = pk2(s[0 * 33], s[1 * 33]); o.y = pk2(s[2 * 33], s[3 * 33]); o.z = pk2(s[4 * 33], s[5 * 33]); o.w = pk2(s[6 * 33], s[7 * 33]);
        *(GAS v4u*)(WT + (size_t)(n0 + nn) * K + k0 + 8 * c) = o; }
    LDS_WAIT(); asm volatile("" ::: "memory");
}
struct CMapWin {
    __device__ __forceinline__ int operator()(int n, float& sc) const {
        sc = 1.f;
        if (n < 9216) { if (n < 1024 || (n >= 4096 && n < 5120)) sc = QSCALE; else if (n >= 8192) sc = 0.125f; return n; }
        if (n < 13312) return n + 80;
        if (n < 13392) { if (n >= 13376) sc = 0.25f; return n - 13312 + 9216; }
        return -1;
    }
};
struct CMapId { __device__ __forceinline__ int operator()(int n, float& sc) const { sc = 1.f; return n; } };
__device__ __forceinline__ void rms_row_to_bf16(const float* xrow, bf16* orow, int lane) {
    const GAS f32x4* xr = (const GAS f32x4*)xrow + lane;
    f32x4 v[8]; float s = 0.f;
#pragma unroll
    for (int j = 0; j < 8; ++j) { v[j] = xr[64 * j]; s += (v[j].x * v[j].x + v[j].y * v[j].y) + (v[j].z * v[j].z + v[j].w * v[j].w); }
    const float rstd = 1.f / sqrtf(wave_sum(s) * (1.f / DMODEL) + RMS_EPS);
    GAS unsigned long long* o8 = (GAS unsigned long long*)orow + lane;
#pragma unroll
    for (int j = 0; j < 8; ++j) o8[64 * j] = (unsigned long long)pk2(v[j].x * rstd, v[j].y * rstd) | ((unsigned long long)pk2(v[j].z * rstd, v[j].w * rstd) << 32);
}
__device__ __forceinline__ void p0_prologue(Frame& F) {
    const int flane = (int)__builtin_amdgcn_mbcnt_hi(~0u, __builtin_amdgcn_mbcnt_lo(~0u, 0u));
    LAS float* scr = (LAS float*)(F.lds + RING_OFF + F.wave * 16384);
    const int gw = F.vcu * NWAVES + F.wave, NGW = F.G * NWAVES;
    constexpr int I_IN = (DMODEL / 64) * (NPACK / 32), I_B = (BW / 64) * (DMODEL / 32), I_O = (DMODEL / 64) * (DMODEL / 32);
    constexpr int NITEMS = I_IN + 2 * I_B + I_O;
    bf16* Win_t = (bf16*)(F.outb + OUT_WIN);
    for (int it = gw; it < NITEMS; it += NGW) {
        int r = it;
        if (r < I_IN) { p0_transpose_item(F.w_in, NIN, DMODEL, Win_t, F.gain, CMapWin{}, scr, r / (NPACK / 32), r % (NPACK / 32), flane); continue; } r -= I_IN;
        if (r < I_B) { p0_transpose_item(F.w_sb, DMODEL, BW, (bf16*)(F.ws + WS_WSB), nullptr, CMapId{}, scr, r / (DMODEL / 32), r % (DMODEL / 32), flane); continue; } r -= I_B;
        if (r < I_B) { p0_transpose_item(F.w_sa, DMODEL, BW, (bf16*)(F.ws + WS_WSA), nullptr, CMapId{}, scr, r / (DMODEL / 32), r % (DMODEL / 32), flane); continue; } r -= I_B;
        p0_transpose_item(F.w_out, DMODEL, DMODEL, (bf16*)(F.ws + WS_WOUT), nullptr, CMapId{}, scr, r / (DMODEL / 32), r % (DMODEL / 32), flane);
    }
    bf16* XN = (bf16*)(F.outb + OUT_XN);
    for (int m = gw; m < M; m += NGW) rms_row_to_bf16(F.x + (size_t)m * DMODEL, XN + (size_t)m * DMODEL, flane);
}
__device__ __forceinline__ void p6_final_norm(Frame& F) {
    const int flane = (int)__builtin_amdgcn_mbcnt_hi(~0u, __builtin_amdgcn_mbcnt_lo(~0u, 0u));
    const int gw = F.vcu * NWAVES + F.wave, NGW = F.G * NWAVES;
    const float* pss = (const float*)(F.ws + WS_PSS);
    f32x4 gv[8];
#pragma unroll
    for (int j = 0; j < 8; ++j) gv[j] = ((const GAS f32x4*)F.fgain)[flane + 64 * j];
    for (int m = gw; m < M; m += NGW) {
        const float part = (flane < 32) ? pss[(size_t)m * 32 + flane] : 0.f;
        const float rstd = 1.f / sqrtf(wave_sum(part) * (1.f / DMODEL) + RMS_EPS);
        GAS f32x4* hr = (GAS f32x4*)(F.out + (size_t)m * DMODEL) + flane;
#pragma unroll
        for (int j = 0; j < 8; ++j) { f32x4 v = hr[64 * j]; v = v * rstd * gv[j]; hr[64 * j] = v; }
    }
}

struct Args { const float* in[7]; float* out; unsigned char* ws; int ph_lo, ph_hi, li, pad; };
typedef const __attribute__((address_space(4))) Args* KArgs;
__device__ __forceinline__ KArgs fresh_args() { KArgs p = (KArgs)__builtin_amdgcn_kernarg_segment_ptr(); asm volatile("" : "+s"(p)); return p; }
__global__ void __launch_bounds__(NWAVES * 64, 2) hsd_fwd(Args args) {
    extern __shared__ __attribute__((aligned(16))) unsigned char lds[];
    Frame F;
    F.lds = (LAS unsigned char*)lds;
    F.MISC = (volatile LAS unsigned*)(F.lds + MISC_OFF);
    F.wave = __builtin_amdgcn_readfirstlane((int)threadIdx.x >> 6);
#define LANE() ((int)__builtin_amdgcn_mbcnt_hi(~0u, __builtin_amdgcn_mbcnt_lo(~0u, 0u)))
#define T0() (F.wave == 0 && LANE() == 0)
    F.G = gridDim.x; { const int bx = blockIdx.x; F.vcu = (F.G % 8 == 0) ? (bx % 8) * (F.G / 8) + bx / 8 : bx; }
    F.ws = args.ws; F.outb = (unsigned char*)args.out; F.out = args.out;
    F.ctl = (gu32*)(F.ws + WS_CTL);
    F.x = args.in[0]; F.gain = args.in[1]; F.w_in = args.in[2]; F.w_sb = args.in[3]; F.w_sa = args.in[4]; F.w_out = args.in[5]; F.fgain = args.in[6];
    for (int u = F.wave * 64 + LANE(); u < (LDS_BYTES - LDSCTL_OFF) / 4; u += NWAVES * 64) ((LAS unsigned*)(F.lds + LDSCTL_OFF))[u] = 0u;
    __syncthreads();
    XcdBarrier bar; bar.bar = (unsigned*)(F.ctl + CW_BAR); bar.x = 0; bar.st = nullptr;
    if (N_LAUNCHES == 1) bar = xcd_barrier_post((unsigned*)(F.ctl + CW_BAR), F.MISC + 8, T0());
#define GRID_BAR() do { if (N_LAUNCHES == 1) { xcd_barrier(bar, T0()); } } while (0)
    const int lo = args.ph_lo, hi = args.ph_hi;
#ifndef PHASE_MASK
#define PHASE_MASK 0x7f
#endif
#define IN(k) ((((PHASE_MASK) >> (k)) & 1) && lo <= (k) && (k) < hi)
#define BOTH(k) (IN(k) && IN((k) + 1))
    const size_t PS = (size_t)M * 1024;
#define REFRESH() KArgs a_ = fresh_args(); F.ws = a_->ws; F.out = a_->out; F.outb = (unsigned char*)F.out; F.x = a_->in[0]; F.gain = a_->in[1]; F.w_in = a_->in[2]; F.w_sb = a_->in[3]; F.w_sa = a_->in[4]; F.w_out = a_->in[5]; F.fgain = a_->in[6]; \
    bf16* P9 = (bf16*)(F.ws + WS_P9); bf16* Gt = (bf16*)(F.ws + WS_G); (void)P9; (void)Gt

    if (IN(0)) { REFRESH(); p0_prologue(F); if (BOTH(0)) GRID_BAR(); }

    if (IN(1)) { REFRESH();
        pg8::Gemm g{(const bf16*)(F.outb + OUT_XN), (const bf16*)(F.outb + OUT_WIN), M, NPACK, DMODEL}; pg8::StaticOrder S; S.init(M, NPACK, F.G, (int)blockIdx.x);
        pg8::EpiProj E{P9, Gt, (bf16*)(F.ws + WS_KIDX), (float*)(F.ws + WS_WIDX)};
        pg8::gemm_phase<pg8::EpiProj, pg8::StaticOrder, true, true>(F.lds + RING_OFF, g, S, E, F.wave);
        if (BOTH(1)) GRID_BAR();
    }

    if (IN(2)) { REFRESH();
#ifndef NO_IDX
        for (int v2 = F.vcu; v2 < 512; v2 += F.G) { const int v = v2 & 255, b = (v >> 7) & 1, p = (v & 127) >> 1, hf = v & 1, c = (v2 < 256) ? p : 127 - p;
            idx::idx_unit(b, c, hf, P9 + 8 * PS, (const bf16*)(F.ws + WS_KIDX), (const float*)(F.ws + WS_WIDX), (idx::u32x2*)(F.ws + WS_MASK), (char*)lds + RING_OFF, F.wave);
            __syncthreads(); }
#endif
#ifndef NO_SB
        for (int u = F.vcu; u < 512; u += F.G) { const int b = u >> 8, h = (u >> 5) & 7, qb = u & 31;
            att::sb_unit(b, h, qb, P9 + 0 * PS, P9 + 1 * PS, P9 + 2 * PS, P9 + 3 * PS, (char*)lds + RING_OFF, F.wave); }
#endif
        if (BOTH(2)) GRID_BAR();
    }

    if (IN(3)) { REFRESH();
        for (int u = F.vcu; u < 256; u += F.G) { const int bh = u >> 4, s = u & 15, b = bh >> 3, h = bh & 7;
            att::sa_unit(b, h, 31 - s, P9 + 4 * PS, P9 + 5 * PS, P9 + 6 * PS, P9 + 7 * PS, (const att::u32x2*)(F.ws + WS_MASK), (char*)lds + RING_OFF, F.wave);
            att::sa_unit(b, h, s, P9 + 4 * PS, P9 + 5 * PS, P9 + 6 * PS, P9 + 7 * PS, (const att::u32x2*)(F.ws + WS_MASK), (char*)lds + RING_OFF, F.wave); }
        if (BOTH(3)) GRID_BAR();
    }

    if (IN(4)) { REFRESH();
        pg8::StaticOrder S; S.init(M, DMODEL, F.G, (int)blockIdx.x);
        { pg8::Gemm g{P9 + 0 * PS, (const bf16*)(F.ws + WS_WSB), M, DMODEL, BW};
          pg8::EpiGate<0> E{Gt, 0, nullptr, (bf16*)(F.ws + WS_T1)};
          pg8::gemm_phase<pg8::EpiGate<0>, pg8::StaticOrder, true, true>(F.lds + RING_OFF, g, S, E, F.wave); }
        { pg8::Gemm g{P9 + 4 * PS, (const bf16*)(F.ws + WS_WSA), M, DMODEL, BW};
          pg8::EpiGate<1> E{Gt, 2048, (const bf16*)(F.ws + WS_T1), (bf16*)(F.ws + WS_MIX)};
          pg8::gemm_phase<pg8::EpiGate<1>, pg8::StaticOrder, true, true>(F.lds + RING_OFF, g, S, E, F.wave); }
        if (BOTH(4)) GRID_BAR();
    }

    if (IN(5)) { REFRESH();
        pg8::Gemm g{(const bf16*)(F.ws + WS_MIX), (const bf16*)(F.ws + WS_WOUT), M, DMODEL, DMODEL}; pg8::StaticOrder S; S.init(M, DMODEL, F.G, (int)blockIdx.x);
        pg8::EpiOut E{F.x, F.out, (float*)(F.ws + WS_PSS)};
        pg8::gemm_phase<pg8::EpiOut, pg8::StaticOrder, true, true>(F.lds + RING_OFF, g, S, E, F.wave);
        if (BOTH(5)) GRID_BAR();
    }

    if (IN(6)) { REFRESH(); p6_final_norm(F); }
#undef IN
#undef BOTH
#undef GRID_BAR
}

extern "C" void kernel_launch(void* const* d_in, const int* in_sizes, int n_in, void* d_out, int out_size, void* d_ws, size_t ws_size, hipStream_t stream) {
    static int grid = 0;
    if (grid == 0) {
        if (n_in != 7 || in_sizes[0] != M * DMODEL || out_size != M * DMODEL || ws_size < WS_END) {
            fprintf(stderr, "kernel_launch: built for 7 inputs, x and out of %d floats, >= %zu bytes of workspace; got n_in %d, in0 %d, out %d, ws %zu; nothing launched\n", M * DMODEL, (size_t)WS_END, n_in, n_in > 0 ? in_sizes[0] : -1, out_size, ws_size); grid = -1; return; }
        int dev = 0, cus = 0, per_cu = 0;
        if (hipGetDevice(&dev) != hipSuccess || hipDeviceGetAttribute(&cus, hipDeviceAttributeMultiprocessorCount, dev) != hipSuccess) { fprintf(stderr, "kernel_launch: device query failed\n"); grid = -1; return; }
        if (hipFuncSetAttribute((const void*)hsd_fwd, hipFuncAttributeMaxDynamicSharedMemorySize, LDS_BYTES) != hipSuccess) { fprintf(stderr, "kernel_launch: hipFuncSetAttribute failed\n"); grid = -1; return; }
        if (hipOccupancyMaxActiveBlocksPerMultiprocessor(&per_cu, (const void*)hsd_fwd, NWAVES * 64, LDS_BYTES) != hipSuccess || per_cu < 1)
            fprintf(stderr, "kernel_launch: note: occupancy query reports %d workgroups per CU\n", per_cu);
        (void)hipGetLastError();
        grid = cus;
    }
    if (grid < 0) return;
    if (hipMemsetAsync((char*)d_ws + WS_CTL, 0, CTL_ZERO_BYTES, stream) != hipSuccess) { fprintf(stderr, "kernel_launch: hipMemsetAsync failed\n"); return; }
    Args a{};
    for (int i = 0; i < 7; ++i) a.in[i] = (const float*)d_in[i];
    a.out = (float*)d_out; a.ws = (unsigned char*)d_ws;
    for (int li = 0; li < N_LAUNCHES; ++li) {
        a.ph_lo = (N_LAUNCHES == 1) ? 0 : li; a.ph_hi = (N_LAUNCHES == 1) ? N_PHASES : li + 1; a.li = li;
        hipLaunchKernelGGL(hsd_fwd, dim3(grid), dim3(NWAVES * 64), LDS_BYTES, stream, a);
        const hipError_t le = hipPeekAtLastError();
        if (le != hipSuccess) { fprintf(stderr, "kernel_launch: launch %d failed: %s\n", li, hipGetErrorName(le)); break; }
    }
}
```
